# Optimizing an MI355X kernel written in HIP

```python
import math
import jax, jax.numpy as jnp
from jax import lax
import numpy as np

D_MODEL = 1024
BATCH = 8
SEQ = 2048
DEPTH = 2
DEC_BATCH = 128
DEC_SEQ = 8
PAST_LEN = 2048
PAGE_SIZE = 128

N_EVEN = (DEPTH + 1) // 2
N_ODD = DEPTH // 2
EPS = 1e-6
ROPE_THETA = 10000.0
Q_BLOCK = 128
NEG_INF = -1e30
FORCE = 1e4

RET_HEADS = 4
RET_DK = 64
RET_DV = 128
RET_CHUNK = 128
A_WIDTH = RET_HEADS * RET_DV

NSA_HEADS = 8
NSA_KV_HEADS = 2
NSA_DH = 64
NSA_HPG = NSA_HEADS // NSA_KV_HEADS
B_WIDTH = NSA_HEADS * NSA_DH
L_CMP = 32
CMP_STRIDE = 16
CMP_RATIO = L_CMP // CMP_STRIDE
L_SEL = 64
N_SEL = 8
WINDOW = 512
N_FULL_KV = 4
N_WIN_KV = 2

S5_WIDTH = D_MODEL
S5_GROUP = 16
S5_GROUPS = S5_WIDTH // S5_GROUP
S5_STATE = 64

EVEN_SPLITS = (RET_HEADS * RET_DK, RET_HEADS * RET_DK, A_WIDTH, A_WIDTH, B_WIDTH, 6 * NSA_KV_HEADS * NSA_DH, 3 * NSA_HEADS, B_WIDTH)
EVEN_IN = 2 * RET_HEADS * RET_DK + 2 * A_WIDTH + 2 * B_WIDTH + 6 * NSA_KV_HEADS * NSA_DH + 3 * NSA_HEADS
MIX_EVEN = A_WIDTH + B_WIDTH

kernel_name = 'hybrid_retention_nsa_s5_step'


def _rmsnorm(x, g):
    xf = x.astype(jnp.float32)
    y = xf * lax.rsqrt(jnp.mean(xf * xf, axis=-1, keepdims=True) + EPS)
    return (y * g.astype(jnp.float32)).astype(x.dtype)


def _rope(x, pos):
    half = x.shape[-1] // 2
    inv = ROPE_THETA ** (-jnp.arange(half, dtype=jnp.float32) / half)
    ang = pos.astype(jnp.float32)[:, None] * inv[None, :]
    cos = jnp.cos(ang)[:, None, :]
    sin = jnp.sin(ang)[:, None, :]
    xf = x.astype(jnp.float32)
    x1, x2 = xf[..., :half], xf[..., half:]
    return jnp.concatenate([x1 * cos - x2 * sin, x2 * cos + x1 * sin], axis=-1).astype(x.dtype)


def _split(x, sizes):
    outs, o = [], 0
    for s in sizes:
        outs.append(x[..., o:o + s])
        o += s
    return outs


def _head_groupnorm(o, g):
    mu = jnp.mean(o, axis=-1, keepdims=True)
    var = jnp.mean(jnp.square(o - mu), axis=-1, keepdims=True)
    y = (o - mu) * lax.rsqrt(var + EPS)
    B, L, H, dv = o.shape
    return y.reshape(B, L, H * dv) * g.astype(jnp.float32)


def _retention(q, k, v, s0):
    f32 = jnp.float32
    q, k, v, s0 = q.astype(f32), k.astype(f32), v.astype(f32), s0.astype(f32)
    B, L, H, dk = q.shape
    dv = v.shape[-1]
    C = min(RET_CHUNK, L)
    n = L // C
    log_g = jnp.log(1.0 - 2.0 ** (-5.0 - jnp.arange(H, dtype=f32)))
    idx = jnp.arange(C, dtype=f32)
    diff = idx[:, None] - idx[None, :]
    causal = diff >= 0
    decay_mat = jnp.exp(jnp.where(causal, diff, 0.0)[None] * log_g[:, None, None]) * causal[None]
    q_decay = jnp.exp((idx + 1.0)[None, :] * log_g[:, None]).T[None, :, :, None]
    k_decay = jnp.exp((C - 1.0 - idx)[None, :] * log_g[:, None]).T[None, :, :, None]
    chunk_decay = jnp.exp(C * log_g)[None, :, None, None]

    def step(S, xs):
        qc, kc, vc = xs
        scores = jnp.einsum('bihd,bjhd->bhij', qc, kc) * decay_mat[None]
        intra = jnp.einsum('bhij,bjhe->bihe', scores, vc)
        cross = jnp.einsum('bihd,bhde->bihe', qc * q_decay, S)
        S_new = S * chunk_decay + jnp.einsum('bjhd,bjhe->bhde', kc * k_decay, vc)
        return S_new, intra + cross

    to_chunks = lambda a: a.reshape(B, n, C, H, a.shape[-1]).transpose(1, 0, 2, 3, 4)
    S_fin, o = lax.scan(step, s0, (to_chunks(q), to_chunks(k), to_chunks(v)))
    o = o.transpose(1, 0, 2, 3, 4).reshape(B, L, H, dv)
    return o, S_fin


def _nsa(q, kv_full, kv_win, gates, cmp_pos, cmp_w):
    f32 = jnp.float32
    B, Tq, H, dh = q.shape
    Tk = kv_full.shape[1]
    Tw = kv_win.shape[1]
    G = NSA_KV_HEADS
    q_pos0 = Tk - Tq
    kw_start = Tk - Tw
    scale = dh ** -0.5

    nh = Tk // CMP_STRIDE
    n_c = nh - CMP_RATIO + 1
    halves = kv_full[:, :nh * CMP_STRIDE, :2].reshape(B, nh, CMP_STRIDE, 2, G, dh)
    comp = None
    for r in range(CMP_RATIO):
        w_r = cmp_w[:, r * CMP_STRIDE:(r + 1) * CMP_STRIDE]
        p_r = cmp_pos[:, r * CMP_STRIDE:(r + 1) * CMP_STRIDE]
        part = jnp.einsum('bnlcgd,clde->bncge', halves, w_r) + jnp.einsum('cld,clde->ce', p_r, w_r)[None, None, :, None, :]
        part = part[:, r:r + n_c]
        comp = part if comp is None else comp + part
    ck, cv = comp[:, :, 0], comp[:, :, 1]
    cmp_end = jnp.arange(n_c, dtype=jnp.int32) * CMP_STRIDE + (L_CMP - 1)

    n_s = -(-Tk // L_SEL)
    tk_pad = n_s * L_SEL
    sel_kv = jnp.pad(kv_full[:, :, 2:4], ((0, 0), (0, tk_pad - Tk), (0, 0), (0, 0), (0, 0)))
    sel_kv = sel_kv.reshape(B, n_s, L_SEL, 2, G, dh).transpose(0, 4, 1, 2, 3, 5)
    ks_blk, vs_blk = sel_kv[..., 0, :], sel_kv[..., 1, :]
    c_start = jnp.arange(n_c, dtype=jnp.int32) * CMP_STRIDE
    s_start = jnp.arange(n_s, dtype=jnp.int32) * L_SEL
    overlap = ((c_start[:, None] < s_start[None, :] + L_SEL) & (s_start[None, :] < c_start[:, None] + L_CMP)).astype(f32)
    n_top = min(N_SEL, n_s)
    blk_ids = jnp.arange(n_s, dtype=jnp.int32)
    bi = jnp.arange(B)[:, None, None, None]
    gi = jnp.arange(G)[None, :, None, None]

    kwp = jnp.pad(kv_win, ((0, 0), (WINDOW, 0), (0, 0), (0, 0), (0, 0)))

    qb = min(Q_BLOCK, Tq)
    nqb = Tq // qb
    qg = q.reshape(B, nqb, qb, G, NSA_HPG, dh).transpose(1, 0, 2, 3, 4, 5)
    gg = gates.reshape(B, nqb, qb, G, NSA_HPG, 3).transpose(1, 0, 2, 3, 4, 5)
    starts = q_pos0 + jnp.arange(nqb, dtype=jnp.int32) * qb

    def block(args):
        qblk, gblk, p0 = args
        tpos = p0 + jnp.arange(qb, dtype=jnp.int32)
        s1 = jnp.einsum('bqghd,bngd->bqghn', qblk, ck).astype(f32) * scale
        vmask = (cmp_end[None, :] <= tpos[:, None])[None, :, None, None, :]
        p1 = jax.nn.softmax(jnp.where(vmask, s1, NEG_INF), axis=-1) * vmask
        o_cmp = jnp.einsum('bqghn,bngd->bqghd', p1.astype(cv.dtype), cv)
        imp = jnp.einsum('bqghn,ns->bqgs', p1, overlap)
        cur = tpos // L_SEL
        forced = (blk_ids[None, :] == 0) | (blk_ids[None, :] == cur[:, None]) | (blk_ids[None, :] == cur[:, None] - 1)
        valid_s = s_start[None, :] <= tpos[:, None]
        score = jnp.where(forced[None, :, None, :], FORCE, imp)
        score = jnp.where(valid_s[None, :, None, :], score, -FORCE)
        _, sel = lax.top_k(score, n_top)
        sel = sel.transpose(0, 2, 1, 3)
        kg = ks_blk[bi, gi, sel].reshape(B, G, qb, n_top * L_SEL, dh)
        vg = vs_blk[bi, gi, sel].reshape(B, G, qb, n_top * L_SEL, dh)
        kpos = (sel[..., None] * L_SEL + jnp.arange(L_SEL, dtype=jnp.int32)).reshape(B, G, qb, n_top * L_SEL)
        m2 = (kpos <= tpos[None, None, :, None]).transpose(0, 2, 1, 3)[:, :, :, None, :]
        s2 = jnp.einsum('bqghd,bgqkd->bqghk', qblk, kg).astype(f32) * scale
        p2 = jax.nn.softmax(jnp.where(m2, s2, NEG_INF), axis=-1)
        o_sel = jnp.einsum('bqghk,bgqkd->bqghd', p2.astype(vg.dtype), vg)
        kwb = lax.dynamic_slice_in_dim(kwp, p0 - kw_start, WINDOW + qb, axis=1)
        kpos_w = p0 - WINDOW + jnp.arange(WINDOW + qb, dtype=jnp.int32)
        m3 = (kpos_w[None, :] <= tpos[:, None]) & (kpos_w[None, :] > tpos[:, None] - WINDOW) & (kpos_w[None, :] >= 0)
        s3 = jnp.einsum('bqghd,bkgd->bqghk', qblk, kwb[:, :, 0]).astype(f32) * scale
        p3 = jax.nn.softmax(jnp.where(m3[None, :, None, None, :], s3, NEG_INF), axis=-1)
        o_win = jnp.einsum('bqghk,bkgd->bqghd', p3.astype(kwb.dtype), kwb[:, :, 1])
        o = gblk[..., 0:1] * o_cmp + gblk[..., 1:2] * o_sel + gblk[..., 2:3] * o_win
        return o.astype(qblk.dtype)

    out = lax.map(block, (qg, gg, starts))
    return out.transpose(1, 0, 2, 3, 4, 5).reshape(B, Tq, H * dh)


def _even_layer(x, pos0, s_ret, kv_past, win_past, norm_g, w_in, w_out, gn_gain, q_norm, k_norm, cmp_pos, cmp_w):
    B, L, _ = x.shape
    pos = pos0 + jnp.arange(L, dtype=jnp.int32)
    h = _rmsnorm(x, norm_g)
    proj = jnp.einsum('bld,de->ble', h, w_in)
    qa, ka, va, za, qn, kvb, gl, zb = _split(proj, EVEN_SPLITS)
    qa = _rope(qa.reshape(B, L, RET_HEADS, RET_DK), pos)
    ka = _rope(ka.reshape(B, L, RET_HEADS, RET_DK), pos) * (RET_DK ** -0.5)
    va = va.reshape(B, L, RET_HEADS, RET_DV)
    oa, s_ret_new = _retention(qa, ka, va, s_ret)
    oa = _head_groupnorm(oa, gn_gain).astype(x.dtype) * jax.nn.silu(za)
    qn = _rope(_rmsnorm(qn.reshape(B, L, NSA_HEADS, NSA_DH), q_norm), pos)
    kvb = kvb.reshape(B, L, 6, NSA_KV_HEADS, NSA_DH)
    k_c = _rope(_rmsnorm(kvb[:, :, 0], k_norm[0]), pos)
    k_s = _rope(_rmsnorm(kvb[:, :, 2], k_norm[1]), pos)
    k_w = _rope(_rmsnorm(kvb[:, :, 4], k_norm[2]), pos)
    full_new = jnp.stack([k_c, kvb[:, :, 1], k_s, kvb[:, :, 3]], axis=2)
    win_new = jnp.stack([k_w, kvb[:, :, 5]], axis=2)
    kv_full = full_new if kv_past is None else jnp.concatenate([kv_past.astype(full_new.dtype), full_new], axis=1)
    kv_win = win_new if win_past is None else jnp.concatenate([win_past.astype(win_new.dtype), win_new], axis=1)
    gates = jax.nn.sigmoid(gl.reshape(B, L, NSA_HEADS, 3))
    ob = _nsa(qn, kv_full, kv_win, gates, cmp_pos, cmp_w) * jax.nn.silu(zb)
    y = x + jnp.einsum('ble,ed->bld', jnp.concatenate([oa, ob], axis=-1), w_out)
    keep = min(WINDOW, kv_win.shape[1])
    return y, s_ret_new, full_new, kv_win[:, kv_win.shape[1] - keep:]


def _complex_affine_combine(e1, e2):
    a1r, a1i, b1r, b1i = e1
    a2r, a2i, b2r, b2i = e2
    return (a1r * a2r - a1i * a2i, a1r * a2i + a1i * a2r,
            a2r * b1r - a2i * b1i + b2r, a2r * b1i + a2i * b1r + b2i)


def _s5(u, x0_re, x0_im, lam_re, lam_im, b_re, b_im, c_re, c_im, d, log_step):
    B, L, E = u.shape
    ug = u.reshape(B, L, S5_GROUPS, S5_GROUP)
    dt = jnp.exp(log_step)[:, None]
    mag = jnp.exp(lam_re * dt)
    ang = lam_im * dt
    ab_re, ab_im = mag * jnp.cos(ang), mag * jnp.sin(ang)
    den = lam_re * lam_re + lam_im * lam_im
    nr = ab_re - 1.0
    f_re = (nr * lam_re + ab_im * lam_im) / den
    f_im = (ab_im * lam_re - nr * lam_im) / den
    bb_re = f_re[..., None] * b_re - f_im[..., None] * b_im
    bb_im = f_re[..., None] * b_im + f_im[..., None] * b_re
    bu_re = jnp.einsum('blgc,gpc->blgp', ug, bb_re)
    bu_im = jnp.einsum('blgc,gpc->blgp', ug, bb_im)
    bu_re = bu_re.at[:, 0].add(ab_re * x0_re - ab_im * x0_im)
    bu_im = bu_im.at[:, 0].add(ab_re * x0_im + ab_im * x0_re)
    a_re = jnp.broadcast_to(ab_re, bu_re.shape)
    a_im = jnp.broadcast_to(ab_im, bu_im.shape)
    _, _, xr, xi = lax.associative_scan(_complex_affine_combine, (a_re, a_im, bu_re, bu_im), axis=1)
    y = jnp.einsum('blgp,gcp->blgc', xr, c_re) - jnp.einsum('blgp,gcp->blgc', xi, c_im)
    y = y.reshape(B, L, E) + d * u
    return y, xr[:, -1], xi[:, -1]


def _odd_layer(x, s_re, s_im, norm_g, w_in, lam_re, lam_im, b_re, b_im, c_re, c_im, d, log_step, glu_w1, glu_w2, w_out):
    f32 = jnp.float32
    h = _rmsnorm(x, norm_g)
    u, z = _split(jnp.einsum('bld,de->ble', h, w_in), (S5_WIDTH, S5_WIDTH))
    y, f_re, f_im = _s5(u.astype(f32), s_re.astype(f32), s_im.astype(f32), lam_re.astype(f32), lam_im.astype(f32),
                        b_re.astype(f32), b_im.astype(f32), c_re.astype(f32), c_im.astype(f32), d.astype(f32), log_step.astype(f32))
    y = jax.nn.gelu(y).astype(x.dtype)
    y = jnp.einsum('ble,ef->blf', y, glu_w1) * jax.nn.sigmoid(jnp.einsum('ble,ef->blf', y, glu_w2))
    y = x + jnp.einsum('ble,ed->bld', y * jax.nn.silu(z), w_out)
    return y, f_re, f_im


def setup_inputs(seed: int = 0) -> dict:
    key = jax.random.key(seed)
    ks = jax.random.split(key, 32)
    f32 = jnp.float32
    n_pages = PAST_LEN // PAGE_SIZE
    n_used = DEC_BATCH * n_pages
    n_phys = n_used + n_used // 4
    w_buf = min(WINDOW, PAST_LEN)
    nrm = lambda k, shape, s: jax.random.normal(k, shape, f32) * s
    gain = lambda k, shape: 1.0 + 0.02 * jax.random.normal(k, shape, f32)
    page_table = jax.random.permutation(ks[0], n_phys)[:n_used].reshape(DEC_BATCH, n_pages).astype(jnp.int32)
    lam_re = -0.5 + 0.01 * jax.random.normal(ks[1], (N_ODD, S5_GROUPS, S5_STATE), f32)
    lam_im = jnp.broadcast_to(math.pi * jnp.arange(S5_STATE, dtype=f32), (N_ODD, S5_GROUPS, S5_STATE))
    log_step = jax.random.uniform(ks[2], (N_ODD, S5_GROUPS), f32, math.log(1e-3), math.log(1e-1))
    return {
        'x_prompt': nrm(ks[3], (BATCH, SEQ, D_MODEL), 1.0),
        'x_sample': nrm(ks[4], (DEC_BATCH, DEC_SEQ, D_MODEL), 1.0),
        'cache_nsa_kv': nrm(ks[5], (N_EVEN, n_phys, PAGE_SIZE, N_FULL_KV, NSA_KV_HEADS, NSA_DH), 1.0),
        'cache_nsa_win': nrm(ks[6], (N_EVEN, DEC_BATCH, w_buf, N_WIN_KV, NSA_KV_HEADS, NSA_DH), 1.0),
        'state_ret': nrm(ks[7], (N_EVEN, DEC_BATCH, RET_HEADS, RET_DK, RET_DV), 0.5),
        'state_ssm_re': nrm(ks[8], (N_ODD, DEC_BATCH, S5_GROUPS, S5_STATE), 0.5),
        'state_ssm_im': nrm(ks[9], (N_ODD, DEC_BATCH, S5_GROUPS, S5_STATE), 0.5),
        'page_table': page_table,
        'norm_even': gain(ks[10], (N_EVEN, D_MODEL)),
        'w_in_even': nrm(ks[11], (N_EVEN, D_MODEL, EVEN_IN), D_MODEL ** -0.5),
        'w_out_even': nrm(ks[12], (N_EVEN, MIX_EVEN, D_MODEL), MIX_EVEN ** -0.5),
        'ret_gn_gain': gain(ks[13], (N_EVEN, A_WIDTH)),
        'nsa_q_norm': gain(ks[14], (N_EVEN, NSA_DH)),
        'nsa_k_norm': gain(ks[15], (N_EVEN, 3, NSA_DH)),
        'nsa_cmp_pos': nrm(ks[16], (N_EVEN, 2, L_CMP, NSA_DH), 0.02),
        'nsa_cmp_w': nrm(ks[17], (N_EVEN, 2, L_CMP, NSA_DH, NSA_DH), (L_CMP * NSA_DH) ** -0.5),
        'norm_odd': gain(ks[18], (N_ODD, D_MODEL)),
        'w_in_odd': nrm(ks[19], (N_ODD, D_MODEL, 2 * S5_WIDTH), D_MODEL ** -0.5),
        'ssm_lambda_re': lam_re,
        'ssm_lambda_im': lam_im,
        'ssm_b_re': nrm(ks[20], (N_ODD, S5_GROUPS, S5_STATE, S5_GROUP), (2 * S5_GROUP) ** -0.5),
        'ssm_b_im': nrm(ks[21], (N_ODD, S5_GROUPS, S5_STATE, S5_GROUP), (2 * S5_GROUP) ** -0.5),
        'ssm_c_re': nrm(ks[22], (N_ODD, S5_GROUPS, S5_GROUP, S5_STATE), S5_STATE ** -0.5),
        'ssm_c_im': nrm(ks[23], (N_ODD, S5_GROUPS, S5_GROUP, S5_STATE), S5_STATE ** -0.5),
        'ssm_d': nrm(ks[24], (N_ODD, S5_WIDTH), 1.0),
        'ssm_log_step': log_step,
        'glu_w1': nrm(ks[25], (N_ODD, S5_WIDTH, S5_WIDTH), S5_WIDTH ** -0.5),
        'glu_w2': nrm(ks[26], (N_ODD, S5_WIDTH, S5_WIDTH), S5_WIDTH ** -0.5),
        'w_out_odd': nrm(ks[27], (N_ODD, S5_WIDTH, D_MODEL), S5_WIDTH ** -0.5),
    }


def reference(x_prompt, x_sample, cache_nsa_kv, cache_nsa_win, state_ret, state_ssm_re, state_ssm_im, page_table,
              norm_even, w_in_even, w_out_even, ret_gn_gain, nsa_q_norm, nsa_k_norm, nsa_cmp_pos, nsa_cmp_w,
              norm_odd, w_in_odd, ssm_lambda_re, ssm_lambda_im, ssm_b_re, ssm_b_im, ssm_c_re, ssm_c_im, ssm_d,
              ssm_log_step, glu_w1, glu_w2, w_out_odd):
    bp = x_prompt.shape[0]
    db = x_sample.shape[0]
    n_pages = page_table.shape[1]
    past_len = n_pages * PAGE_SIZE
    yp, ys = x_prompt, x_sample
    ret_p, ret_s, kv_p, kv_s, win_p, win_s = [], [], [], [], [], []
    sre_p, sim_p, sre_s, sim_s = [], [], [], []
    for layer in range(DEPTH):
        li = layer // 2
        if layer % 2 == 0:
            ew = (norm_even[li], w_in_even[li], w_out_even[li], ret_gn_gain[li], nsa_q_norm[li], nsa_k_norm[li],
                  nsa_cmp_pos[li], nsa_cmp_w[li])
            s0 = jnp.zeros((bp, RET_HEADS, RET_DK, RET_DV), jnp.float32)
            yp, sr, kvr, wr = _even_layer(yp, 0, s0, None, None, *ew)
            ret_p.append(sr); kv_p.append(kvr); win_p.append(wr)
            past = cache_nsa_kv[li][page_table].reshape(db, past_len, N_FULL_KV, NSA_KV_HEADS, NSA_DH)
            ys, sr2, kvr2, wr2 = _even_layer(ys, past_len, state_ret[li], past, cache_nsa_win[li], *ew)
            ret_s.append(sr2); kv_s.append(kvr2); win_s.append(wr2)
        else:
            ow = (norm_odd[li], w_in_odd[li], ssm_lambda_re[li], ssm_lambda_im[li], ssm_b_re[li], ssm_b_im[li],
                  ssm_c_re[li], ssm_c_im[li], ssm_d[li], ssm_log_step[li], glu_w1[li], glu_w2[li], w_out_odd[li])
            z0 = jnp.zeros((bp, S5_GROUPS, S5_STATE), jnp.float32)
            yp, fr, fi = _odd_layer(yp, z0, z0, *ow)
            sre_p.append(fr); sim_p.append(fi)
            ys, fr2, fi2 = _odd_layer(ys, state_ssm_re[li], state_ssm_im[li], *ow)
            sre_s.append(fr2); sim_s.append(fi2)
    return (yp, ys, jnp.stack(ret_p), jnp.stack(ret_s), jnp.stack(kv_p), jnp.stack(kv_s), jnp.stack(win_p),
            jnp.stack(win_s), jnp.stack(sre_p), jnp.stack(sim_p), jnp.stack(sre_s), jnp.stack(sim_s))
```

```cpp
#include <hip/hip_runtime.h>
#include <cstdio>
#include <cstdint>
#include <cmath>
#ifndef MK_N_LAUNCHES
#define MK_N_LAUNCHES 1
#endif
namespace pg8 {
#define PG8_LAS __attribute__((address_space(3)))
typedef unsigned short bf16_t;
typedef short bf16x8 __attribute__((ext_vector_type(8)));
typedef float f32x4 __attribute__((ext_vector_type(4)));
typedef unsigned u32x4 __attribute__((ext_vector_type(4)));
constexpr int BM = 256, BK = 64, HALF = 128, HTB = HALF * BK * 2  , STAGE_BYTES = 8 * HTB, NXCD = 8, WGM = 8;

__host__ __device__ __forceinline__ int lds_byte(int r, int c) { const int st = (r >> 4) * 2 + (c >> 5), rr = r & 15, cc = c & 31, ob = rr * 64 + cc * 2; return st * 1024 + (ob ^ (((ob >> 9) & 1) << 5)); }
__host__ __device__ __forceinline__ void stage_rc(int b, int& R, int& C) { const int st = b / 1024, sb = b % 1024, swz = sb ^ (((sb >> 9) & 1) << 5); R = (st >> 1) * 16 + swz / 64; C = (st & 1) * 32 + (swz % 64) / 2; }
__host__ __device__ __forceinline__ int perm32(int rho) { const int n = rho >> 4, i = rho & 15; return 8 * (i >> 2) + 4 * n + (i & 3); }

struct Unit { int pm, pn; };
struct Gemm { const bf16_t* A; const bf16_t* Bt; int M, N, K; };

struct StaticOrder {
    int nM, nN, nwg, G, c;
    __host__ __device__ void init(int M, int N, int G_, int c_) { nM = M / BM; nN = N / BM; nwg = nM * nN; G = G_; c = c_; }
    __host__ __device__ bool next(int i, Unit& u) const {
        const long L = (long)i * G + c; if (L >= nwg) return false;
        int wgid = (int)L; { const int q = nwg / NXCD, r = nwg % NXCD, xcd = wgid % NXCD, off = wgid / NXCD; wgid = (xcd < r ? xcd * (q + 1) : r * (q + 1) + (xcd - r) * q) + off; }
        const int nig = WGM * nN, gid = wgid / nig, fm = gid * WGM, gsz = (nM - fm) < WGM ? (nM - fm) : WGM;
        u.pm = fm + ((wgid % nig) % gsz); u.pn = (wgid % nig) / gsz; return true;
    }
    __device__ __forceinline__ void a_ready(const Unit&) const {}
    __device__ __forceinline__ void done(const Unit&) const {}
};

typedef float f32x2 __attribute__((ext_vector_type(2)));
typedef __bf16 bf16x2_t __attribute__((ext_vector_type(2)));
__device__ __forceinline__ unsigned cvt_pk_bf16(float lo, float hi) { f32x2 v = {lo, hi}; bf16x2_t b = __builtin_convertvector(v, bf16x2_t); return __builtin_bit_cast(unsigned, b); }
__device__ __forceinline__ u32x4 pack8(const float* v) { u32x4 w; w.x = cvt_pk_bf16(v[0], v[1]); w.y = cvt_pk_bf16(v[2], v[3]); w.z = cvt_pk_bf16(v[4], v[5]); w.w = cvt_pk_bf16(v[6], v[7]); return w; }
__device__ __forceinline__ float bf2f(unsigned short h) { return __uint_as_float(((unsigned)h) << 16); }
__device__ __forceinline__ void unpack8(u32x4 w, float* v) { v[0] = __uint_as_float(w.x << 16); v[1] = __uint_as_float(w.x & 0xffff0000u); v[2] = __uint_as_float(w.y << 16); v[3] = __uint_as_float(w.y & 0xffff0000u);
    v[4] = __uint_as_float(w.z << 16); v[5] = __uint_as_float(w.z & 0xffff0000u); v[6] = __uint_as_float(w.w << 16); v[7] = __uint_as_float(w.w & 0xffff0000u); }
__device__ __forceinline__ float sigmoidf_(float x) { return 1.f / (1.f + __expf(-x)); }
__device__ __forceinline__ float siluf_(float x) { return x / (1.f + __expf(-x)); }

constexpr float QSCALE = 0.125f * 1.4426950408889634f;
constexpr size_t O_Y = 0, O_RETP = 17825792, O_RETS = 18087936, O_KVP = 22282240, O_KVS = 30670848, O_WINP = 31195136, O_WINS = 32243712,
                 O_SREP = 49020928, O_SIMP = 49053696, O_SRES = 49086464, O_SIMS = 49610752, O_END = 50135040;

struct EpiL0 {
    static constexpr bool PERM = true, AFTER_DRAIN = false;
    bf16_t *QA, *KA, *VA, *ZA, *QN, *ZB, *KXP, *KXS; float *GATES, *out; const float *ropeC, *ropeS, *qnorm, *knorm;
    __device__ __forceinline__ void operator()(const f32x4 (&acc)[2][2][4][2], const Unit& u, int wr, int wc, int fr, int fq) const {
        const int pn = u.pn; const bool samp = u.pm >= 64; const int d0 = 8 * fq;
        bool do_norm = false, do_rope = false, gates = false; float scale = 1.f; const float* nw = nullptr;
        bf16_t* bdst = nullptr; int bpitch = 0, bmode = 0, fmode = 0, type = 0, g = 0;
        if (pn == 0) { do_rope = true; bdst = QA + wc * 64; bpitch = 256; }
        else if (pn == 1) { do_rope = true; scale = 0.125f; bdst = KA + wc * 64; bpitch = 256; }
        else if (pn < 4) { bdst = VA + (pn - 2) * 256 + wc * 64; bpitch = 512; }
        else if (pn < 6) { bdst = ZA + (pn - 4) * 256 + wc * 64; bpitch = 512; }
        else if (pn < 8) { do_norm = true; do_rope = true; nw = qnorm; scale = QSCALE; bdst = QN + (pn - 6) * 256 + wc * 64; bpitch = 512; }
        else if (pn < 11) { const int slot = (pn - 8) * 4 + wc; type = slot >> 1; g = slot & 1; if (!(type & 1)) { do_norm = true; do_rope = true; nw = knorm + (type >> 1) * 64; }
            bmode = 1; bpitch = 64; bdst = samp ? KXS + (size_t)type * 131072 + g * 512 : KXP + (size_t)type * 2097152 + (size_t)g * 131072; fmode = type < 4 ? 1 : 2; }
        else if (pn < 13) { bdst = ZB + (pn - 11) * 256 + wc * 64; bpitch = 512; }
        else { gates = true; }
        float nwl[8], nwh[8];
        if (do_norm) {
#pragma unroll
            for (int j = 0; j < 8; ++j) { nwl[j] = nw[d0 + j]; nwh[j] = nw[32 + d0 + j]; } }
#pragma unroll
        for (int ai = 0; ai < 2; ++ai)
#pragma unroll
            for (int m = 0; m < 4; ++m) {
                const int row = u.pm * BM + ai * HALF + wr * 64 + m * 16 + fr;
                int b, t, pos; if (!samp) { b = row >> 11; t = row & 2047; pos = t; } else { const int rs = row - 16384; b = rs >> 3; t = rs & 7; pos = 2048 + t; }
                float lo[8], hi[8];
#pragma unroll
                for (int n = 0; n < 2; ++n)
#pragma unroll
                    for (int i = 0; i < 4; ++i) { lo[4 * n + i] = acc[ai][0][m][n][i]; hi[4 * n + i] = acc[ai][1][m][n][i]; }
                if (gates) {
                    if (wc == 0 && fq < 3) {
                        f32x4 a, c;
#pragma unroll
                        for (int i = 0; i < 4; ++i) { a[i] = sigmoidf_(lo[i]); c[i] = sigmoidf_(lo[4 + i]); }
                        *(f32x4*)(GATES + (size_t)row * 24 + d0) = a; *(f32x4*)(GATES + (size_t)row * 24 + d0 + 4) = c; }
                    continue; }
                if (do_norm) {
                    float ss = 0.f;
#pragma unroll
                    for (int j = 0; j < 8; ++j) ss += lo[j] * lo[j] + hi[j] * hi[j];
                    ss += __shfl_xor(ss, 16); ss += __shfl_xor(ss, 32);
                    const float rstd = __builtin_amdgcn_rsqf(ss * (1.f / 64.f) + 1e-6f);
#pragma unroll
                    for (int j = 0; j < 8; ++j) { lo[j] *= rstd * nwl[j]; hi[j] *= rstd * nwh[j]; } }
                if (do_rope) {
                    const f32x4 c0 = *(const f32x4*)(ropeC + pos * 32 + d0), c1 = *(const f32x4*)(ropeC + pos * 32 + d0 + 4);
                    const f32x4 s0 = *(const f32x4*)(ropeS + pos * 32 + d0), s1 = *(const f32x4*)(ropeS + pos * 32 + d0 + 4);
#pragma unroll
                    for (int j = 0; j < 8; ++j) { const float c = j < 4 ? c0[j & 3] : c1[j & 3], s = j < 4 ? s0[j & 3] : s1[j & 3]; const float x1 = lo[j], x2 = hi[j]; lo[j] = x1 * c - x2 * s; hi[j] = x2 * c + x1 * s; } }
                if (fmode) {
                    float* fp = nullptr;
                    if (fmode == 1) fp = out + (samp ? O_KVS : O_KVP) + (size_t)(samp ? row - 16384 : row) * 512 + type * 128 + g * 64;
                    else if (samp) fp = out + O_WINS + ((size_t)(b * 512 + 504 + t) * 2 + (type - 4)) * 128 + g * 64;
                    else if (t >= 1536) fp = out + O_WINP + ((size_t)(b * 512 + t - 1536) * 2 + (type - 4)) * 128 + g * 64;
                    if (fp) { *(f32x4*)(fp + d0) = (f32x4){lo[0], lo[1], lo[2], lo[3]}; *(f32x4*)(fp + d0 + 4) = (f32x4){lo[4], lo[5], lo[6], lo[7]};
                              *(f32x4*)(fp + 32 + d0) = (f32x4){hi[0], hi[1], hi[2], hi[3]}; *(f32x4*)(fp + 32 + d0 + 4) = (f32x4){hi[4], hi[5], hi[6], hi[7]}; } }
                if (scale != 1.f) {
#pragma unroll
                    for (int j = 0; j < 8; ++j) { lo[j] *= scale; hi[j] *= scale; } }
                const size_t ridx = bmode ? (samp ? (size_t)(b * 16 + t) : (size_t)(b * 4096 + t)) : (size_t)row;
                bf16_t* bp = bdst + ridx * bpitch;
                *(u32x4*)(bp + d0) = pack8(lo); *(u32x4*)(bp + 32 + d0) = pack8(hi);
            }
    }
};

struct EpiOut0 {
    static constexpr bool PERM = true, AFTER_DRAIN = false;
    const float *xp, *xs; float* y; bf16_t* yb; float* ss;
    __device__ __forceinline__ void operator()(const f32x4 (&acc)[2][2][4][2], const Unit& u, int wr, int wc, int fr, int fq) const {
        const float* xb = u.pm >= 64 ? xs - (size_t)16384 * 1024 : xp;
        const int c0 = u.pn * BM + wc * 32 + 8 * fq;
#pragma unroll
        for (int ai = 0; ai < 2; ++ai)
#pragma unroll
            for (int m = 0; m < 4; ++m) {
                const int row = u.pm * BM + ai * HALF + wr * 64 + m * 16 + fr; float sq = 0.f;
#pragma unroll
                for (int bj = 0; bj < 2; ++bj) {
                    const size_t off = (size_t)row * 1024 + c0 + bj * HALF;
                    const f32x4 x0 = *(const f32x4*)(xb + off), x1 = *(const f32x4*)(xb + off + 4);
                    const f32x4 v0 = acc[ai][bj][m][0] + x0, v1 = acc[ai][bj][m][1] + x1;
                    *(f32x4*)(y + off) = v0; *(f32x4*)(y + off + 4) = v1;
                    float v[8] = {v0[0], v0[1], v0[2], v0[3], v1[0], v1[1], v1[2], v1[3]};
#pragma unroll
                    for (int j = 0; j < 8; ++j) sq += v[j] * v[j];
                    *(u32x4*)(yb + off) = pack8(v); }
                sq += __shfl_xor(sq, 16); sq += __shfl_xor(sq, 32);
                if (fq == 0) atomicAdd(ss + row, sq);
            }
    }
};

struct EpiL1 {
    static constexpr bool PERM = true, AFTER_DRAIN = false;
    const float* ss; bf16_t *U, *Z1;
    __device__ __forceinline__ void operator()(const f32x4 (&acc)[2][2][4][2], const Unit& u, int wr, int wc, int fr, int fq) const {
        const int c0 = u.pn * BM + wc * 32 + 8 * fq;
#pragma unroll
        for (int ai = 0; ai < 2; ++ai)
#pragma unroll
            for (int m = 0; m < 4; ++m) {
                const int row = u.pm * BM + ai * HALF + wr * 64 + m * 16 + fr;
                const float rstd = __builtin_amdgcn_rsqf(ss[row] * (1.f / 1024.f) + 1e-6f);
#pragma unroll
                for (int bj = 0; bj < 2; ++bj) {
                    const int c = c0 + bj * HALF; float v[8];
#pragma unroll
                    for (int i = 0; i < 4; ++i) { v[i] = acc[ai][bj][m][0][i] * rstd; v[4 + i] = acc[ai][bj][m][1][i] * rstd; }
                    bf16_t* p = c < 1024 ? U + ((size_t)(c >> 4) * 17408 + row) * 16 + (c & 15) : Z1 + (size_t)row * 1024 + (c - 1024);
                    *(u32x4*)p = pack8(v); }
            }
    }
};

struct EpiGLU {
    static constexpr bool PERM = true, AFTER_DRAIN = false;
    const bf16_t* Z1; bf16_t* V1;
    __device__ __forceinline__ void operator()(const f32x4 (&acc)[2][2][4][2], const Unit& u, int wr, int wc, int fr, int fq) const {
        const int c = u.pn * 128 + wc * 32 + 8 * fq;
#pragma unroll
        for (int ai = 0; ai < 2; ++ai)
#pragma unroll
            for (int m = 0; m < 4; ++m) {
                const int row = u.pm * BM + ai * HALF + wr * 64 + m * 16 + fr;
                float z[8]; unpack8(*(const u32x4*)(Z1 + (size_t)row * 1024 + c), z); float v[8];
#pragma unroll
                for (int i = 0; i < 4; ++i) { v[i] = acc[ai][0][m][0][i] * sigmoidf_(acc[ai][1][m][0][i]) * siluf_(z[i]); v[4 + i] = acc[ai][0][m][1][i] * sigmoidf_(acc[ai][1][m][1][i]) * siluf_(z[4 + i]); }
                *(u32x4*)(V1 + (size_t)row * 1024 + c) = pack8(v);
            }
    }
};

struct EpiFinal {
    static constexpr bool PERM = true, AFTER_DRAIN = false;
    float* y;
    __device__ __forceinline__ void operator()(const f32x4 (&acc)[2][2][4][2], const Unit& u, int wr, int wc, int fr, int fq) const {
        const int c0 = u.pn * BM + wc * 32 + 8 * fq;
#pragma unroll
        for (int ai = 0; ai < 2; ++ai)
#pragma unroll
            for (int m = 0; m < 4; ++m) {
                const int row = u.pm * BM + ai * HALF + wr * 64 + m * 16 + fr;
#pragma unroll
                for (int bj = 0; bj < 2; ++bj) { float* p = y + (size_t)row * 1024 + c0 + bj * HALF;
                    *(f32x4*)p = *(const f32x4*)p + acc[ai][bj][m][0]; *(f32x4*)(p + 4) = *(const f32x4*)(p + 4) + acc[ai][bj][m][1]; }
            }
    }
};

template <class Epi, class Sched, bool ALIGN_EPI = false, bool SP2 = false>
__device__ __forceinline__ void gemm_phase(PG8_LAS unsigned char* lds, const Gemm g, const Sched& S, const Epi& E) {
    const int tid = threadIdx.x, wid = __builtin_amdgcn_readfirstlane(tid >> 6), lane = tid & 63, wr = wid >> 2, wc = wid & 3, fr = lane & 15, fq = lane >> 4;
    const int K = g.K, nt = K / BK;
    unsigned voffA[2], voffB[2];
#pragma unroll
    for (int i = 0; i < 2; ++i) { int R, C; stage_rc(tid * 16 + i * 8192, R, C); const int Rb = Epi::PERM ? ((R & ~31) + perm32(R & 31)) : R;
        voffA[i] = (unsigned)(R * K + C) * 2u; voffB[i] = (unsigned)(Rb * K + C) * 2u; }
    const size_t kstep = (size_t)(BK * 2);
    const size_t hstep = (size_t)HALF * K * 2;
    const size_t tstep = 2 * hstep;
    const unsigned ldsw = (unsigned)wid * 1024u;
    const int aoff = lds_byte(wr * 64 + fr, fq * 8), boff = lds_byte(wc * 32 + fr, fq * 8);
#define PG8_SA(b, h) (((b) * 2 + (h)) * HTB)
#define PG8_SB(b, h) ((4 + (b) * 2 + (h)) * HTB)
#define PG8_STAGE(bufoff, gbase, voff) do { _Pragma("unroll") for (int _i = 0; _i < 2; ++_i) \
        __builtin_amdgcn_global_load_lds((const unsigned*)((const char*)(gbase) + (voff)[_i]), (PG8_LAS unsigned*)(lds + (bufoff) + ldsw + _i * 8192), 16, 0, 0); } while (0)
#define PG8_LDA(dst, b, h) do { _Pragma("unroll") for (int m = 0; m < 4; ++m) _Pragma("unroll") for (int k = 0; k < 2; ++k) dst[m][k] = *(const PG8_LAS bf16x8*)(lds + PG8_SA(b, h) + aoff + m * 2048 + k * 1024); } while (0)
#define PG8_LDB(dst, b, h) do { _Pragma("unroll") for (int n = 0; n < 2; ++n) _Pragma("unroll") for (int k = 0; k < 2; ++k) dst[n][k] = *(const PG8_LAS bf16x8*)(lds + PG8_SB(b, h) + boff + n * 2048 + k * 1024); } while (0)
#define PG8_MMA(ai, bj, At, Bt) do { __builtin_amdgcn_s_setprio(1); _Pragma("unroll") for (int m = 0; m < 4; ++m) _Pragma("unroll") for (int n = 0; n < 2; ++n) _Pragma("unroll") for (int k = 0; k < 2; ++k) \
        acc[ai][bj][m][n] = __builtin_amdgcn_mfma_f32_16x16x32_bf16(Bt[n][k], At[m][k], acc[ai][bj][m][n], 0, 0, 0); __builtin_amdgcn_s_setprio(0); } while (0)
#define PG8_WAIT_V(n) asm volatile("s_waitcnt vmcnt(" #n ")" ::: "memory")
#define PG8_WAIT_L(n) asm volatile("s_waitcnt lgkmcnt(" #n ")" ::: "memory")
#define PG8_BAR __builtin_amdgcn_s_barrier()
#define PG8_SCHED __builtin_amdgcn_sched_barrier(0)
    Unit cur, nxt; int ui = 0;
    if (!S.next(0, cur)) return;
    f32x4 acc[2][2][4][2];
#pragma unroll
    for (int a = 0; a < 2; ++a)
#pragma unroll
        for (int b = 0; b < 2; ++b)
#pragma unroll
            for (int m = 0; m < 4; ++m)
#pragma unroll
                for (int n = 0; n < 2; ++n) acc[a][b][m][n] = (f32x4){0.f, 0.f, 0.f, 0.f};
    bf16x8 At[4][2], B0[2][2], B1[2][2];
    const char* cA = (const char*)g.A + (size_t)cur.pm * tstep; const char* cB = (const char*)g.Bt + (size_t)cur.pn * tstep;
    S.a_ready(cur);
    if constexpr (SP2) {
        PG8_STAGE(PG8_SB(0, 0), cB, voffB); PG8_STAGE(PG8_SB(0, 1), cB + hstep, voffB); PG8_STAGE(PG8_SA(0, 0), cA, voffA); PG8_STAGE(PG8_SA(0, 1), cA + hstep, voffA);
        if (wr == 1) PG8_BAR;
        PG8_WAIT_V(2); PG8_BAR;
        PG8_STAGE(PG8_SB(1, 0), cB + kstep, voffB); PG8_STAGE(PG8_SA(1, 0), cA + kstep, voffA); PG8_STAGE(PG8_SB(1, 1), cB + hstep + kstep, voffB);
        PG8_WAIT_V(6); PG8_BAR;
    } else {
        PG8_STAGE(PG8_SB(0, 0), cB, voffB); PG8_STAGE(PG8_SA(0, 0), cA, voffA); PG8_STAGE(PG8_SB(0, 1), cB + hstep, voffB); PG8_STAGE(PG8_SA(0, 1), cA + hstep, voffA);
        if (wr == 1) PG8_BAR;
        PG8_WAIT_V(4); PG8_BAR;
        PG8_STAGE(PG8_SB(1, 0), cB + kstep, voffB); PG8_STAGE(PG8_SA(1, 0), cA + kstep, voffA); PG8_STAGE(PG8_SB(1, 1), cB + hstep + kstep, voffB);
        PG8_WAIT_V(6); PG8_BAR;
    }
    for (;;) {
        const bool has_next = S.next(ui + 1, nxt);
        const char* nA = has_next ? (const char*)g.A + (size_t)nxt.pm * tstep : cA; const char* nB = has_next ? (const char*)g.Bt + (size_t)nxt.pn * tstep : cB;
        for (int t = 0; t < nt; t += 2) {
            const bool last = (t == nt - 2);
            const char* a1 = cA + (size_t)(t + 1) * kstep;
            const char* a2 = last ? nA : cA + (size_t)(t + 2) * kstep; const char* b2 = last ? nB : cB + (size_t)(t + 2) * kstep;
            const char* a3 = a2 + kstep; const char* b3 = b2 + kstep;
            if (last && has_next) S.a_ready(nxt);
            if constexpr (SP2) {
            PG8_LDB(B0, 0, 0); PG8_LDB(B1, 0, 1); PG8_SCHED; PG8_LDA(At, 0, 0); PG8_STAGE(PG8_SA(1, 1), a1 + hstep, voffA);
            PG8_WAIT_V(8); PG8_WAIT_L(0); PG8_BAR; PG8_MMA(0, 0, At, B0); PG8_MMA(0, 1, At, B1); PG8_BAR; PG8_SCHED;
            PG8_LDA(At, 0, 1); PG8_STAGE(PG8_SB(0, 0), b2, voffB); PG8_STAGE(PG8_SB(0, 1), b2 + hstep, voffB); PG8_STAGE(PG8_SA(0, 0), a2, voffA);
            PG8_WAIT_V(8); PG8_WAIT_L(0); PG8_BAR; PG8_MMA(1, 0, At, B0); PG8_MMA(1, 1, At, B1); PG8_BAR; PG8_SCHED;
            PG8_LDB(B0, 1, 0); PG8_LDB(B1, 1, 1); PG8_SCHED; PG8_LDA(At, 1, 0); PG8_STAGE(PG8_SA(0, 1), a2 + hstep, voffA);
            PG8_WAIT_V(8); PG8_WAIT_L(0); PG8_BAR; PG8_MMA(0, 0, At, B0); PG8_MMA(0, 1, At, B1); PG8_BAR; PG8_SCHED;
            PG8_LDA(At, 1, 1); PG8_STAGE(PG8_SB(1, 0), b3, voffB); PG8_STAGE(PG8_SB(1, 1), b3 + hstep, voffB); PG8_STAGE(PG8_SA(1, 0), a3, voffA);
            PG8_WAIT_V(8); PG8_WAIT_L(0); PG8_BAR; PG8_MMA(1, 0, At, B0); PG8_MMA(1, 1, At, B1); PG8_BAR; PG8_SCHED;
            } else {
            PG8_LDB(B0, 0, 0); PG8_SCHED; PG8_LDA(At, 0, 0); PG8_STAGE(PG8_SA(1, 1), a1 + hstep, voffA);
            PG8_WAIT_L(8); PG8_BAR; PG8_WAIT_L(0); PG8_MMA(0, 0, At, B0); PG8_BAR; PG8_SCHED;
            PG8_LDB(B1, 0, 1); PG8_STAGE(PG8_SB(0, 0), b2, voffB);
            PG8_BAR; PG8_WAIT_L(0); PG8_MMA(0, 1, At, B1); PG8_BAR;
            PG8_LDA(At, 0, 1); PG8_STAGE(PG8_SA(0, 0), a2, voffA);
            PG8_BAR; PG8_WAIT_L(0); PG8_MMA(1, 0, At, B0); PG8_BAR; PG8_SCHED;
            PG8_STAGE(PG8_SB(0, 1), b2 + hstep, voffB);
            PG8_WAIT_V(6); PG8_BAR; PG8_MMA(1, 1, At, B1); PG8_BAR;
            PG8_LDB(B0, 1, 0); PG8_SCHED; PG8_LDA(At, 1, 0); PG8_STAGE(PG8_SA(0, 1), a2 + hstep, voffA);
            PG8_WAIT_L(8); PG8_BAR; PG8_WAIT_L(0); PG8_MMA(0, 0, At, B0); PG8_BAR; PG8_SCHED;
            PG8_LDB(B1, 1, 1); PG8_STAGE(PG8_SB(1, 0), b3, voffB);
            PG8_BAR; PG8_WAIT_L(0); PG8_MMA(0, 1, At, B1); PG8_BAR;
            PG8_LDA(At, 1, 1); PG8_STAGE(PG8_SA(1, 0), a3, voffA);
            PG8_BAR; PG8_WAIT_L(0); PG8_MMA(1, 0, At, B0); PG8_BAR; PG8_SCHED;
            PG8_STAGE(PG8_SB(1, 1), b3 + hstep, voffB);
            PG8_WAIT_V(6); PG8_BAR; PG8_MMA(1, 1, At, B1); PG8_BAR;
            }
        }
        if constexpr (ALIGN_EPI) { if (wr == 0) PG8_BAR; }
        if constexpr (!Epi::AFTER_DRAIN) { E(acc, cur, wr, wc, fr, fq); S.done(cur); }
        if (!has_next) break;
#pragma unroll
        for (int a = 0; a < 2; ++a)
#pragma unroll
            for (int b = 0; b < 2; ++b)
#pragma unroll
                for (int m = 0; m < 4; ++m)
#pragma unroll
                    for (int n = 0; n < 2; ++n) acc[a][b][m][n] = (f32x4){0.f, 0.f, 0.f, 0.f};
        cur = nxt; cA = nA; cB = nB; ++ui;
        if constexpr (ALIGN_EPI) { if (wr == 1) PG8_BAR; }
    }
    PG8_WAIT_V(0);
    if constexpr (!ALIGN_EPI) { if (wr == 0) PG8_BAR; }
    PG8_BAR;
    if constexpr (Epi::AFTER_DRAIN) { E.fused(acc, cur, wr, wc, fr, fq, lds, wid, lane); S.done(cur); }
#undef PG8_SA
#undef PG8_SB
#undef PG8_STAGE
#undef PG8_LDA
#undef PG8_LDB
#undef PG8_MMA
#undef PG8_WAIT_V
#undef PG8_WAIT_L
#undef PG8_BAR
#undef PG8_SCHED
}
}
#define LAS __attribute__((address_space(3)))
#define GAS __attribute__((address_space(1)))
typedef unsigned short bf16;
typedef short bf16x8 __attribute__((ext_vector_type(8)));
typedef short s16x4 __attribute__((ext_vector_type(4)));
typedef float f32x4 __attribute__((ext_vector_type(4)));
typedef float f32x16 __attribute__((ext_vector_type(16)));
typedef unsigned u32x4 __attribute__((ext_vector_type(4)));
typedef unsigned u32x2 __attribute__((ext_vector_type(2)));
typedef GAS unsigned gu32;
#define RLX_AGENT __ATOMIC_RELAXED, __HIP_MEMORY_SCOPE_AGENT
using pg8::cvt_pk_bf16; using pg8::pack8; using pg8::unpack8; using pg8::bf2f; using pg8::sigmoidf_; using pg8::siluf_;
using pg8::O_Y; using pg8::O_RETP; using pg8::O_RETS; using pg8::O_KVP; using pg8::O_KVS; using pg8::O_WINP; using pg8::O_WINS; using pg8::O_SREP; using pg8::O_SIMP; using pg8::O_SRES; using pg8::O_SIMS; using pg8::O_END;

constexpr int TP = 16384, TS = 1024, TT = 17408;
__device__ __forceinline__ void sincos_d(double x, float& s, float& c) {
    const double TWO_PI = 6.283185307179586476925, PI = 3.14159265358979323846;
    double r = x - rint(x / TWO_PI) * TWO_PI; double sg = 1.0;
    if (r > 0.5 * PI) { r = PI - r; sg = -1.0; } else if (r < -0.5 * PI) { r = -PI - r; sg = -1.0; }
    const double r2 = r * r;
    const double sp = r * (1.0 + r2 * (-1.0 / 6 + r2 * (1.0 / 120 + r2 * (-1.0 / 5040 + r2 * (1.0 / 362880 + r2 * (-1.0 / 39916800 + r2 * (1.0 / 6227020800.0)))))));
    const double cp = 1.0 + r2 * (-0.5 + r2 * (1.0 / 24 + r2 * (-1.0 / 720 + r2 * (1.0 / 40320 + r2 * (-1.0 / 3628800 + r2 * (1.0 / 479001600.0 + r2 * (-1.0 / 87178291200.0)))))));
    s = (float)sp; c = (float)(sg * cp);
}

namespace at {
typedef LAS const char* lcp;
typedef short v4i16_t __attribute__((ext_vector_type(4)));
__device__ __forceinline__ int crow(int r, int hi) { return (r & 3) + 8 * (r >> 2) + 4 * hi; }
__device__ __forceinline__ f32x16 mfma32(bf16x8 a, bf16x8 b, f32x16 c) { return __builtin_amdgcn_mfma_f32_32x32x16_bf16(a, b, c, 0, 0, 0); }
__device__ __forceinline__ s16x4 vtr(lcp p) { return __builtin_bit_cast(s16x4, __builtin_amdgcn_ds_read_tr16_b64_v4i16((LAS v4i16_t*)p)); }
__device__ __forceinline__ void qkt(f32x16& p0, f32x16& p1, lcp Kslot, const bf16x8* qr, int r32, int hi) {
    lcp kb = Kslot + hi * 1024 + r32 * 16;
    f32x16 z;
#pragma unroll
    for (int r = 0; r < 16; ++r) z[r] = 0.f;
    p0 = z; p1 = z;
#pragma unroll
    for (int d0 = 0; d0 < 4; ++d0) {
        const bf16x8 b0 = *(LAS const bf16x8*)(kb + d0 * 2048), b1 = *(LAS const bf16x8*)(kb + d0 * 2048 + 512);
        p0 = mfma32(b0, qr[d0], p0); p1 = mfma32(b1, qr[d0], p1); }
}
__device__ __forceinline__ int vlane_off(int lane) { const int hi = lane >> 5; return ((lane >> 4) & 1) * 32 + (lane & 3) * 8 + (4 * hi + ((lane & 15) >> 2)) * 64; }
__device__ __forceinline__ void pv(f32x16* o, lcp vp, const bf16x8* pa) {
#pragma unroll
    for (int d0 = 0; d0 < 2; ++d0)
#pragma unroll
        for (int ks = 0; ks < 4; ++ks) {
            const s16x4 lo = vtr(vp + d0 * 4096 + ks * 1024), hh = vtr(vp + d0 * 4096 + ks * 1024 + 512);
            const bf16x8 vf = {lo[0], lo[1], lo[2], lo[3], hh[0], hh[1], hh[2], hh[3]};
            o[d0] = mfma32(pa[ks], vf, o[d0]); }
}
__device__ __forceinline__ bf16x8 pk8(const f32x16& p, int b) { u32x4 w; w.x = cvt_pk_bf16(p[b], p[b + 1]); w.y = cvt_pk_bf16(p[b + 2], p[b + 3]); w.z = cvt_pk_bf16(p[b + 4], p[b + 5]); w.w = cvt_pk_bf16(p[b + 6], p[b + 7]); return __builtin_bit_cast(bf16x8, w); }
__device__ __forceinline__ void pack_p(bf16x8* pa, const f32x16& p0, const f32x16& p1) { pa[0] = pk8(p0, 0); pa[1] = pk8(p0, 8); pa[2] = pk8(p1, 0); pa[3] = pk8(p1, 8); }
__device__ __forceinline__ float rowmax32(const f32x16& p0, const f32x16& p1) {
    float m = fmaxf(p0[0], p1[0]);
#pragma unroll
    for (int r = 1; r < 16; ++r) m = fmaxf(m, fmaxf(p0[r], p1[r]));
    return fmaxf(m, __shfl_xor(m, 32));
}
struct St { f32x16 o[2]; float m, l; };
__device__ __forceinline__ void st_init(St& s) {
#pragma unroll
    for (int r = 0; r < 16; ++r) { s.o[0][r] = 0.f; s.o[1][r] = 0.f; }
    s.m = -INFINITY; s.l = 0.f; }
__device__ __forceinline__ void st_update(St& st, f32x16& p0, f32x16& p1, lcp vp, LAS float* wsf, int r32, int hi) {
    const float rm = rowmax32(p0, p1);
    const float mn = fmaxf(st.m, rm);
    const float mu = (mn == -INFINITY) ? 0.f : mn;
    const float alpha = __builtin_amdgcn_exp2f(st.m - mu);
    float s = 0.f;
#pragma unroll
    for (int r = 0; r < 16; ++r) { p0[r] = __builtin_amdgcn_exp2f(p0[r] - mu); p1[r] = __builtin_amdgcn_exp2f(p1[r] - mu); s += p0[r] + p1[r]; }
    s += __shfl_xor(s, 32);
    st.l = st.l * alpha + s; st.m = mn;
    if (__builtin_amdgcn_ballot_w64(alpha != 1.f) != 0ull) {
        if (hi == 0) wsf[r32] = alpha;
#pragma unroll
        for (int r = 0; r < 16; ++r) { const float a = wsf[crow(r, hi)]; st.o[0][r] *= a; st.o[1][r] *= a; } }
    bf16x8 pa[4]; pack_p(pa, p0, p1);
    pv(st.o, vp, pa);
}
__device__ __forceinline__ void glds16(const void* gsrc, unsigned lds_dst) { unsigned keep;
    asm volatile("s_mov_b32 %0, m0\n\ts_mov_b32 m0, %2\n\ts_nop 0\n\tglobal_load_lds_dwordx4 %1, off\n\ts_mov_b32 m0, %0" : "=&s"(keep) : "v"(gsrc), "s"(lds_dst) : "memory"); }
#define AT_WAIT_BAR(N) asm volatile("s_waitcnt vmcnt(" #N ") lgkmcnt(0)\n\ts_barrier" ::: "memory")
__device__ __forceinline__ void acc_scaled(f32x16* fin, const f32x16* o, float w, LAS float* wsf, int r32, int hi) {
    if (hi == 0) wsf[r32] = w;
#pragma unroll
    for (int r = 0; r < 16; ++r) { const float a = wsf[crow(r, hi)]; fin[0][r] += a * o[0][r]; fin[1][r] += a * o[1][r]; }
}
__device__ __forceinline__ void acc_stage(LAS float* stg, const f32x16* o, float w, LAS float* wsf, int r32, int hi, bool first) {
    if (hi == 0) wsf[r32] = w;
#pragma unroll
    for (int r = 0; r < 16; ++r) { const int orow = crow(r, hi); const float a = wsf[orow];
        const float v0 = a * o[0][r], v1 = a * o[1][r];
        if (first) { stg[orow * 64 + r32] = v0; stg[orow * 64 + 32 + r32] = v1; } else { stg[orow * 64 + r32] += v0; stg[orow * 64 + 32 + r32] += v1; } }
}
__device__ __forceinline__ u32x4 ldk_reg(const bf16* src, int pitch, int wid, int lane) { return *(const u32x4*)(src + (size_t)lane * pitch + wid * 8); }
__device__ __forceinline__ u32x4 ldv_reg(const bf16* src, int pitch, int wid, int lane) { return *(const u32x4*)(src + (size_t)(16 * (wid & 3) + (lane >> 2)) * pitch + (wid >> 2) * 32 + (lane & 3) * 8); }
__device__ __forceinline__ void st_slot(LAS char* slot, u32x4 v, int wid, int lane) { *(LAS u32x4*)(slot + wid * 1024 + lane * 16) = v; }
__device__ __forceinline__ void wave_tile_f32(const float* ksrc, const float* vsrc, size_t rs, LAS char* kslot, LAS char* vslot, int lane) {
    const int q = lane & 15, rr = lane >> 4;
#pragma unroll 1
    for (int i0 = 0; i0 < 16; i0 += 4) {
        f32x4 kv[4], vv[4];
#pragma unroll
        for (int i = 0; i < 4; ++i) { const size_t ro = (size_t)(4 * (i0 + i) + rr) * rs + 4 * q; kv[i] = __builtin_nontemporal_load((const f32x4*)(ksrc + ro)); vv[i] = __builtin_nontemporal_load((const f32x4*)(vsrc + ro)); }
#pragma unroll
        for (int i = 0; i < 4; ++i) { const int row = 4 * (i0 + i) + rr;
            u32x2 a, b; a.x = cvt_pk_bf16(kv[i][0], kv[i][1]); a.y = cvt_pk_bf16(kv[i][2], kv[i][3]); b.x = cvt_pk_bf16(vv[i][0], vv[i][1]); b.y = cvt_pk_bf16(vv[i][2], vv[i][3]);
            *(LAS u32x2*)(kslot + (q >> 1) * 1024 + row * 16 + (q & 1) * 8) = a;
            *(LAS u32x2*)(vslot + (q >> 3) * 4096 + row * 64 + (q & 7) * 8) = b; }
    }
}
__device__ __forceinline__ void wave_tile_new8(const bf16* ksrc, const bf16* vsrc, LAS char* kslot, LAS char* vslot, int lane) {
#pragma unroll
    for (int i = 0; i < 8; ++i) { const int pid = lane + 64 * i, row = pid >> 3, ch = pid & 7;
        u32x4 k = {0u, 0u, 0u, 0u}, v = {0u, 0u, 0u, 0u};
        if (row < 8) { k = *(const u32x4*)(ksrc + row * 64 + ch * 8); v = *(const u32x4*)(vsrc + row * 64 + ch * 8); }
        *(LAS u32x4*)(kslot + ch * 1024 + row * 16) = k;
        *(LAS u32x4*)(vslot + (ch >> 2) * 4096 + row * 64 + (ch & 3) * 16) = v; }
}
}
constexpr int NWAVES = 8;
constexpr int LDS_BYTES = 163840;
constexpr int MISC_OFF = LDS_BYTES - 512;
constexpr size_t MiB = 1u << 20;
constexpr size_t WS_CTL = 0, CTL_ZERO_BYTES = 1 * MiB;
constexpr size_t WS_W0T = 1 * MiB, WS_WO0T = 9 * MiB, WS_W1T = 11 * MiB, WS_WGT = 15 * MiB, WS_WO1T = 19 * MiB;
constexpr size_t WS_WCT = 21 * MiB, WS_CCONST = 21 * MiB + 768 * 1024, WS_ROPEC = 22 * MiB, WS_ROPES = 22 * MiB + 512 * 1024;
constexpr size_t WS_MT = 24 * MiB, WS_BST = 32 * MiB, WS_CXT = 36 * MiB, WS_L16 = 40 * MiB, WS_L8I = 40 * MiB + 256 * 1024;
constexpr size_t WS_H0 = 48 * MiB, WS_QA = 84 * MiB, WS_KA = 94 * MiB, WS_VA = 104 * MiB, WS_ZA = 122 * MiB, WS_QN = 140 * MiB, WS_ZB = 158 * MiB, WS_GATES = 176 * MiB;
constexpr size_t WS_KXP = 180 * MiB, WS_KXS = 206 * MiB, WS_CKP = 208 * MiB, WS_CKS = 209 * MiB, WS_RETA = 218 * MiB, WS_MIX = 236 * MiB, WS_Y0B = 272 * MiB;
constexpr size_t WS_U = 308 * MiB, WS_Z1 = 344 * MiB, WS_YG = 380 * MiB, WS_V1 = 416 * MiB, WS_END = 452 * MiB;
constexpr int CW_TMO = 0, CW_WQ = 64  , CW_BAR = 4096, CW_SS = 16384  ;
static_assert((CW_SS + TT) * 4 <= (int)CTL_ZERO_BYTES, "ctl");

struct Frame {
    LAS unsigned char* lds; volatile LAS unsigned* MISC; gu32* ctl;
    int tid, lane, wave, G;
    const float* in[29]; const int* ptab; float* out; unsigned char* ws;
};
#define WSP(T, off) ((T*)(F.ws + (off)))
#define UNIT_IDS() int tid = F.tid; asm volatile("" : "+v"(tid)); const int lane = tid & 63; const int wid = __builtin_amdgcn_readfirstlane(tid >> 6); (void)lane; (void)wid

__device__ __forceinline__ float wave_sum(float v) {
#pragma unroll
    for (int o = 1; o < 64; o <<= 1) v += __shfl_xor(v, o);
    return v;
}
__device__ __forceinline__ int wq_next(Frame& F, int q) {
    __syncthreads();
    if (F.tid == 0) F.MISC[16] = __hip_atomic_fetch_add(F.ctl + CW_WQ + 64 * q, 1u, RLX_AGENT);
    __syncthreads();
    return (int)F.MISC[16];
}

__device__ __forceinline__ void nsa_imp(const f32x16& a0, const f32x16& a1, const f32x16& b0, const f32x16& b1, LAS float* imp, int lane) {
    const int r32 = lane & 31, hi = lane >> 5;
    float eprev = 0.f;
#pragma unroll
    for (int i = 0; i < 16; ++i) {
        const f32x16& X = (i < 4) ? a0 : (i < 8) ? a1 : (i < 12) ? b0 : b1; const int q4 = i & 3;
        const float G = (X[4 * q4] + X[4 * q4 + 1]) + (X[4 * q4 + 2] + X[4 * q4 + 3]), E = X[4 * q4 + 3];
        const float eo = __shfl_xor(E, 32);
        float v = G + (hi ? eo : eprev); eprev = eo;
        v += __shfl_xor(v, 1); v += __shfl_xor(v, 2);
        if ((r32 & 3) == 0) imp[(r32 >> 2) * 33 + 2 * i + hi] = v; }
}
__device__ __forceinline__ unsigned nsa_rank(LAS float* imp, int cur, bool samp, int lane) {
    const int r32 = lane & 31;
    const int q = lane >> 3, j = lane & 7;
    float sc[4]; int rk[4];
#pragma unroll
    for (int k = 0; k < 4; ++k) { const int s = 4 * j + k; const bool valid = s <= cur, forced = (s == 0) || (s == cur) || (s == cur - 1);
        sc[k] = valid ? (forced ? 1e4f : imp[q * 33 + s]) : -1e4f; rk[k] = (samp && !forced) ? 1 : 0; }
#pragma unroll 4
    for (int s2 = 0; s2 < 32; ++s2) {
        const bool valid = s2 <= cur, forced = (s2 == 0) || (s2 == cur) || (s2 == cur - 1);
        const float v2 = valid ? (forced ? 1e4f : imp[q * 33 + s2]) : -1e4f;
#pragma unroll
        for (int k = 0; k < 4; ++k) rk[k] += (v2 > sc[k] || (v2 == sc[k] && s2 < 4 * j + k)) ? 1 : 0; }
    unsigned mask = 0u;
#pragma unroll
    for (int k = 0; k < 4; ++k) if (4 * j + k <= cur && rk[k] < 8) mask |= 1u << (4 * j + k);
    mask |= __shfl_xor(mask, 1); mask |= __shfl_xor(mask, 2); mask |= __shfl_xor(mask, 4);
    return (unsigned)__shfl((int)mask, 8 * (r32 >> 2));
}

__device__ __forceinline__ void nsa_cmp(f32x16* oc, LAS float* imp, at::lcp k0, at::lcp k1, at::lcp v0, at::lcp v1, bool two, int nmax, const bf16x8* qr, int lane) {
    const int r32 = lane & 31, hi = lane >> 5;
    f32x16 a0, a1, b0, b1;
    at::qkt(a0, a1, k0, qr, r32, hi);
    if (two) at::qkt(b0, b1, k1, qr, r32, hi);
#pragma unroll
    for (int r = 0; r < 16; ++r) { const int n = at::crow(r, hi);
        if (n > nmax) a0[r] = -INFINITY; if (n + 32 > nmax) a1[r] = -INFINITY;
        if (!two || n + 64 > nmax) b0[r] = -INFINITY; if (!two || n + 96 > nmax) b1[r] = -INFINITY; }
    float rm = fmaxf(at::rowmax32(a0, a1), at::rowmax32(b0, b1));
    const float mu = (rm == -INFINITY) ? 0.f : rm;
    float s = 0.f;
#pragma unroll
    for (int r = 0; r < 16; ++r) { a0[r] = __builtin_amdgcn_exp2f(a0[r] - mu); a1[r] = __builtin_amdgcn_exp2f(a1[r] - mu); b0[r] = __builtin_amdgcn_exp2f(b0[r] - mu); b1[r] = __builtin_amdgcn_exp2f(b1[r] - mu);
        s += (a0[r] + a1[r]) + (b0[r] + b1[r]); }
    s += __shfl_xor(s, 32);
    const float inv = s > 0.f ? 1.f / s : 0.f;
#pragma unroll
    for (int r = 0; r < 16; ++r) { a0[r] *= inv; a1[r] *= inv; b0[r] *= inv; b1[r] *= inv; }
    nsa_imp(a0, a1, b0, b1, imp, lane);
    bf16x8 pa[4], pb[4]; at::pack_p(pa, a0, a1); at::pack_p(pb, b0, b1);
    asm volatile("" : "+v"(pa[0]), "+v"(pa[1]), "+v"(pa[2]), "+v"(pa[3]), "+v"(pb[0]), "+v"(pb[1]), "+v"(pb[2]), "+v"(pb[3]));
#pragma unroll
    for (int r = 0; r < 16; ++r) { oc[0][r] = 0.f; oc[1][r] = 0.f; }
    at::pv(oc, v0, pa);
    if (two) at::pv(oc, v1, pb);
}

__device__ __forceinline__ void nsa_prompt_unit(Frame& F, int b, int g, int c) {
    UNIT_IDS(); const int r32 = lane & 31, hi = lane >> 5;
    LAS char* L = (LAS char*)F.lds;
    LAS char* KS0 = L; LAS char* KS1 = L + 16384; LAS char* VS0 = L + 8192; LAS char* VS1 = L + 24576;
    LAS float* stg = (LAS float*)(L + 81920 + 8192 * wid); LAS float* wsf = (LAS float*)(L + 147456 + 512 * wid); LAS float* imp = (LAS float*)(L + 151552 + 1152 * wid);
    const int voff = at::vlane_off(lane);
    const int ql = 8 * wid + (r32 >> 2), h = r32 & 3, tpos = 64 * c + ql, head = 4 * g + h;
    const size_t token = (size_t)b * 2048 + tpos;
    const bf16* QN = WSP(const bf16, WS_QN); const float* GT = WSP(const float, WS_GATES);
    bf16x8 qr[4];
#pragma unroll
    for (int d0 = 0; d0 < 4; ++d0) qr[d0] = *(const bf16x8*)(QN + token * 512 + head * 64 + d0 * 16 + hi * 8);
    const float g0 = GT[token * 24 + head * 3 + 0], g1 = GT[token * 24 + head * 3 + 1], g2 = GT[token * 24 + head * 3 + 2];
    unsigned selm;
#ifndef X_NO_CMP
    {
        const bf16* CK = WSP(const bf16, WS_CKP) + ((size_t)(0 * 8 + b) * 2 + g) * 8192; const bf16* CV = WSP(const bf16, WS_CKP) + ((size_t)(1 * 8 + b) * 2 + g) * 8192;
        const bool two = c >= 16;
        at::st_slot(KS0, at::ldk_reg(CK, 64, wid, lane), wid, lane); at::st_slot(VS0, at::ldv_reg(CV, 64, wid, lane), wid, lane);
        if (two) { at::st_slot(KS1, at::ldk_reg(CK + 4096, 64, wid, lane), wid, lane); at::st_slot(VS1, at::ldv_reg(CV + 4096, 64, wid, lane), wid, lane); }
        __syncthreads();
        f32x16 oc[2];
        const int nmax = (tpos - 31) >> 4;
        nsa_cmp(oc, imp, KS0, KS1, VS0 + voff, VS1 + voff, two, nmax, qr, lane);
        selm = nsa_rank(imp, c, false, lane);
        at::acc_stage(stg, oc, g0, wsf, r32, hi, true);
        __syncthreads();
    }
#else
    selm = 0xffffffffu;
#endif
    __builtin_amdgcn_sched_barrier(0);
#ifndef X_NO_LOOP
    const unsigned lds0 = (unsigned)(size_t)L;
    const unsigned kdst = (unsigned)__builtin_amdgcn_readfirstlane((int)(lds0 + wid * 1024)), vdst = kdst + 8192;
    const int koff = lane * 64 + wid * 8, voffg = (16 * (wid & 3) + (lane >> 2)) * 64 + (wid >> 2) * 32 + (lane & 3) * 8;
    asm volatile("s_waitcnt vmcnt(0)" ::: "memory");
#pragma unroll 1
    for (int br = 0; br < 2; ++br) {
        const bf16* Kb = WSP(const bf16, WS_KXP) + ((size_t)((br ? 4 : 2) * 8 + b) * 2 + g) * 131072;
        const bf16* Vb = WSP(const bf16, WS_KXP) + ((size_t)((br ? 5 : 3) * 8 + b) * 2 + g) * 131072;
        const int t0 = br ? (c > 8 ? c - 8 : 0) : 0, nt = c - t0 + 1;
        at::St st; at::st_init(st);
#define NSA_DMA(j, slot) do { at::glds16(Kb + (size_t)(t0 + (j)) * 4096 + koff, kdst + (unsigned)(slot) * 16384u); at::glds16(Vb + (size_t)(t0 + (j)) * 4096 + voffg, vdst + (unsigned)(slot) * 16384u); } while (0)
        NSA_DMA(0, 0); if (nt > 1) NSA_DMA(1, 1); if (nt > 2) NSA_DMA(2, 2);
        int sl_cur = 0, sl_new = 3;
#pragma unroll 1
        for (int i = 0; i < nt; ++i) {
            const int t = t0 + i, ahead = nt - 1 - i;
            if (ahead >= 3) { NSA_DMA(i + 3, sl_new); sl_new = sl_new == 4 ? 0 : sl_new + 1; }
            if (ahead >= 3) AT_WAIT_BAR(6); else if (ahead == 2) AT_WAIT_BAR(4); else if (ahead == 1) AT_WAIT_BAR(2); else AT_WAIT_BAR(0);
            LAS char* Kc = L + sl_cur * 16384; LAS char* Vc = Kc + 8192; sl_cur = sl_cur == 4 ? 0 : sl_cur + 1;
            f32x16 p0, p1; at::qkt(p0, p1, Kc, qr, r32, hi);
            bool rowoff; int lo_excl, hi_incl;
            if (br == 0) { rowoff = !((selm >> t) & 1u); lo_excl = -1; hi_incl = (t == c) ? ql : 63; }
            else { rowoff = false; lo_excl = (t == c - 8) ? ql : -1; hi_incl = (t == c) ? ql : 63; }
#pragma unroll
            for (int r = 0; r < 16; ++r) { const int kv = at::crow(r, hi);
                if (rowoff || kv <= lo_excl || kv > hi_incl) p0[r] = -INFINITY;
                if (rowoff || kv + 32 <= lo_excl || kv + 32 > hi_incl) p1[r] = -INFINITY; }
            at::st_update(st, p0, p1, Vc + voff, wsf, r32, hi);
        }
#undef NSA_DMA
        at::acc_stage(stg, st.o, (br ? g2 : g1) / st.l, wsf, r32, hi, false);
        AT_WAIT_BAR(0);
    }
#endif
    __builtin_amdgcn_sched_barrier(0);
    const bf16* ZB = WSP(const bf16, WS_ZB); bf16* MIX = WSP(bf16, WS_MIX);
#pragma unroll
    for (int i = 0; i < 4; ++i) { const int row = i * 8 + (lane >> 3), ch = lane & 7;
        const size_t tok = (size_t)b * 2048 + 64 * c + 8 * wid + (row >> 2); const int hd = 4 * g + (row & 3);
        float z[8], v[8]; unpack8(*(const u32x4*)(ZB + tok * 512 + hd * 64 + ch * 8), z);
        const f32x4 x0 = *(LAS const f32x4*)(stg + row * 64 + ch * 8), x1 = *(LAS const f32x4*)(stg + row * 64 + ch * 8 + 4);
#pragma unroll
        for (int j = 0; j < 4; ++j) { v[j] = x0[j] * siluf_(z[j]); v[4 + j] = x1[j] * siluf_(z[4 + j]); }
        *(u32x4*)(MIX + tok * 1024 + 512 + hd * 64 + ch * 8) = pack8(v); }
}

__device__ __forceinline__ void nsa_sample_unit(Frame& F, int b, int g) {
    UNIT_IDS(); const int r32 = lane & 31, hi = lane >> 5;
    LAS char* L = (LAS char*)F.lds;
    LAS char* KP = L + 16384 * wid; LAS char* VP = KP + 8192;
    LAS float* wsf = (LAS float*)(L + 131072 + 512 * wid); LAS float* imp = (LAS float*)(L + 135168 + 1152 * wid);
    LAS float* MM = (LAS float*)(L + 144384); LAS float* LL = (LAS float*)(L + 146432); LAS float* OC = (LAS float*)(L + 148480); LAS float* GW = (LAS float*)(L + 156672);
    const int voff = at::vlane_off(lane);
    const int ql = r32 >> 2, h = r32 & 3, head = 4 * g + h;
    const size_t token = (size_t)TP + b * 8 + ql;
    const bf16* QN = WSP(const bf16, WS_QN); const float* GT = WSP(const float, WS_GATES);
    bf16x8 qr[4];
#pragma unroll
    for (int d0 = 0; d0 < 4; ++d0) qr[d0] = *(const bf16x8*)(QN + token * 512 + head * 64 + d0 * 16 + hi * 8);
    unsigned selm;
    {
        const bf16* CK = WSP(const bf16, WS_CKS) + ((size_t)(0 * 128 + b) * 2 + g) * 8192; const bf16* CV = WSP(const bf16, WS_CKS) + ((size_t)(1 * 128 + b) * 2 + g) * 8192;
        at::st_slot(L, at::ldk_reg(CK, 64, wid, lane), wid, lane); at::st_slot(L + 8192, at::ldv_reg(CV, 64, wid, lane), wid, lane);
        at::st_slot(L + 16384, at::ldk_reg(CK + 4096, 64, wid, lane), wid, lane); at::st_slot(L + 24576, at::ldv_reg(CV + 4096, 64, wid, lane), wid, lane);
        __syncthreads();
        f32x16 oc[2];
        nsa_cmp(oc, imp, L, L + 16384, L + 8192 + voff, L + 24576 + voff, true, 126, qr, lane);
        selm = nsa_rank(imp, 32, true, lane);
        if (wid == 0) {
#pragma unroll
            for (int r = 0; r < 16; ++r) { const int orow = at::crow(r, hi); OC[orow * 64 + r32] = oc[0][r]; OC[orow * 64 + 32 + r32] = oc[1][r]; }
            if (hi == 0) { GW[r32] = GT[token * 24 + head * 3 + 0]; GW[32 + r32] = GT[token * 24 + head * 3 + 1]; GW[64 + r32] = GT[token * 24 + head * 3 + 2]; } }
        __syncthreads();
    }
    unsigned un = selm;
#pragma unroll
    for (int o = 4; o < 32; o <<= 1) un |= __shfl_xor(un, o);
    un = (unsigned)__builtin_amdgcn_readfirstlane(un);
    at::St ss, sw; at::st_init(ss);
    const float* cache = F.in[2]; const float* cwin = F.in[3];
    const bf16* KXS = WSP(const bf16, WS_KXS);
    int idx = 0;
#pragma unroll 1
    for (int s = 0; s <= 32; ++s) {
        if (s < 32 && !((un >> s) & 1u)) continue;
        if (((idx++) & 7) != wid) continue;
        if (s < 32) { const int page = F.ptab[b * 16 + (s >> 1)];
            const float* base = cache + ((size_t)page * 128 + (s & 1) * 64) * 512 + g * 64;
            at::wave_tile_f32(base + 2 * 128, base + 3 * 128, 512, KP, VP, lane); }
        else at::wave_tile_new8(KXS + (size_t)2 * 131072 + (size_t)b * 1024 + g * 512, KXS + (size_t)3 * 131072 + (size_t)b * 1024 + g * 512, KP, VP, lane);
        f32x16 p0, p1; at::qkt(p0, p1, KP, qr, r32, hi);
        const bool rowoff = s < 32 ? !((selm >> s) & 1u) : false; const int hi_incl = s < 32 ? 63 : ql;
#pragma unroll
        for (int r = 0; r < 16; ++r) { const int kv = at::crow(r, hi); if (rowoff || kv > hi_incl) p0[r] = -INFINITY; if (rowoff || kv + 32 > hi_incl) p1[r] = -INFINITY; }
        at::st_update(ss, p0, p1, VP + voff, wsf, r32, hi);
    }
    __builtin_amdgcn_sched_barrier(0);
    at::st_init(sw);
#pragma unroll 1
    for (int j = 0; j <= 8; ++j) {
        if (((idx++) & 7) != wid) continue;
        if (j < 8) { const float* base = cwin + ((size_t)b * 512 + 64 * j) * 256 + g * 64; at::wave_tile_f32(base, base + 128, 256, KP, VP, lane); }
        else at::wave_tile_new8(KXS + (size_t)4 * 131072 + (size_t)b * 1024 + g * 512, KXS + (size_t)5 * 131072 + (size_t)b * 1024 + g * 512, KP, VP, lane);
        f32x16 p0, p1; at::qkt(p0, p1, KP, qr, r32, hi);
        const int lo_excl = j == 0 ? ql : -1, hi_incl = j == 8 ? ql : 63;
#pragma unroll
        for (int r = 0; r < 16; ++r) { const int kv = at::crow(r, hi); if (kv <= lo_excl || kv > hi_incl) p0[r] = -INFINITY; if (kv + 32 <= lo_excl || kv + 32 > hi_incl) p1[r] = -INFINITY; }
        at::st_update(sw, p0, p1, VP + voff, wsf, r32, hi);
    }
    if (hi == 0) { MM[(0 * 8 + wid) * 32 + r32] = ss.m; MM[(1 * 8 + wid) * 32 + r32] = sw.m; }
    __syncthreads();
    {
        float Ms = -INFINITY, Mw = -INFINITY;
#pragma unroll
        for (int w = 0; w < 8; ++w) { Ms = fmaxf(Ms, MM[(0 * 8 + w) * 32 + r32]); Mw = fmaxf(Mw, MM[(1 * 8 + w) * 32 + r32]); }
        const float fs = __builtin_amdgcn_exp2f(ss.m - Ms), fw = __builtin_amdgcn_exp2f(sw.m - Mw);
        if (hi == 0) { LL[(0 * 8 + wid) * 32 + r32] = ss.l * fs; LL[(1 * 8 + wid) * 32 + r32] = sw.l * fw; }
        LAS float* OPs = (LAS float*)(L + (0 * 8 + wid) * 8192); LAS float* OPw = (LAS float*)(L + (1 * 8 + wid) * 8192);
        if (hi == 0) wsf[r32] = fs;
#pragma unroll
        for (int r = 0; r < 16; ++r) { const int orow = at::crow(r, hi); const float a = wsf[orow]; OPs[orow * 64 + r32] = ss.o[0][r] * a; OPs[orow * 64 + 32 + r32] = ss.o[1][r] * a; }
        if (hi == 0) wsf[32 + r32] = fw;
#pragma unroll
        for (int r = 0; r < 16; ++r) { const int orow = at::crow(r, hi); const float a = wsf[32 + orow]; OPw[orow * 64 + r32] = sw.o[0][r] * a; OPw[orow * 64 + 32 + r32] = sw.o[1][r] * a; }
    }
    __syncthreads();
    {
        const int row = tid >> 4, dq = (tid & 15) * 4;
        f32x4 os = {0.f, 0.f, 0.f, 0.f}, ow = {0.f, 0.f, 0.f, 0.f}; float ls = 0.f, lw = 0.f;
#pragma unroll
        for (int w = 0; w < 8; ++w) { os = os + *(LAS const f32x4*)(L + (0 * 8 + w) * 8192 + (row * 64 + dq) * 4); ow = ow + *(LAS const f32x4*)(L + (1 * 8 + w) * 8192 + (row * 64 + dq) * 4);
            ls += LL[(0 * 8 + w) * 32 + row]; lw += LL[(1 * 8 + w) * 32 + row]; }
        const f32x4 oc = *(LAS const f32x4*)(OC + row * 64 + dq);
        const float w0 = GW[row], w1 = GW[32 + row] / ls, w2 = GW[64 + row] / lw;
        const size_t tok = (size_t)TP + b * 8 + (row >> 2); const int hd = 4 * g + (row & 3);
        const bf16* ZB = WSP(const bf16, WS_ZB); bf16* MIX = WSP(bf16, WS_MIX);
        const u32x2 zr = *(const u32x2*)(ZB + tok * 512 + hd * 64 + dq);
        const float z0 = __uint_as_float(zr.x << 16), z1 = __uint_as_float(zr.x & 0xffff0000u), z2 = __uint_as_float(zr.y << 16), z3 = __uint_as_float(zr.y & 0xffff0000u);
        const float v0 = (w0 * oc[0] + w1 * os[0] + w2 * ow[0]) * siluf_(z0), v1 = (w0 * oc[1] + w1 * os[1] + w2 * ow[1]) * siluf_(z1);
        const float v2 = (w0 * oc[2] + w1 * os[2] + w2 * ow[2]) * siluf_(z2), v3 = (w0 * oc[3] + w1 * os[3] + w2 * ow[3]) * siluf_(z3);
        u32x2 o; o.x = cvt_pk_bf16(v0, v1); o.y = cvt_pk_bf16(v2, v3);
        *(u32x2*)(MIX + tok * 1024 + 512 + hd * 64 + dq) = o;
    }
}
__device__ __forceinline__ float ret_log2g(int h) { return log2f(1.f - exp2f(-5.f - (float)h)); }
__device__ __forceinline__ void ret_r1_unit(Frame& F, int b, int h, int c) {
    UNIT_IDS();
    LAS float* Kd = (LAS float*)F.lds; LAS float* Vl = (LAS float*)(F.lds + 32768);
    const bf16* KA = WSP(const bf16, WS_KA); const bf16* VA = WSP(const bf16, WS_VA);
    const size_t tok0 = (size_t)b * 2048 + 128 * c; const float l2g = ret_log2g(h);
    for (int p = tid; p < 128 * 8; p += 512) { const int j = p >> 3, ch = p & 7; float v[8]; unpack8(*(const u32x4*)(KA + (tok0 + j) * 256 + h * 64 + ch * 8), v);
        const float dec = exp2f((float)(127 - j) * l2g);
        *(LAS f32x4*)(Kd + j * 64 + ch * 8) = (f32x4){v[0] * dec, v[1] * dec, v[2] * dec, v[3] * dec}; *(LAS f32x4*)(Kd + j * 64 + ch * 8 + 4) = (f32x4){v[4] * dec, v[5] * dec, v[6] * dec, v[7] * dec}; }
    for (int p = tid; p < 128 * 16; p += 512) { const int j = p >> 4, ch = p & 15; float v[8]; unpack8(*(const u32x4*)(VA + (tok0 + j) * 512 + h * 128 + ch * 8), v);
        *(LAS f32x4*)(Vl + j * 128 + ch * 8) = (f32x4){v[0], v[1], v[2], v[3]}; *(LAS f32x4*)(Vl + j * 128 + ch * 8 + 4) = (f32x4){v[4], v[5], v[6], v[7]}; }
    __syncthreads();
    const int dvq = tid & 31, dkg = tid >> 5;
    f32x4 acc[4];
#pragma unroll
    for (int i = 0; i < 4; ++i) acc[i] = (f32x4){0.f, 0.f, 0.f, 0.f};
#pragma unroll 4
    for (int j = 0; j < 128; ++j) { const f32x4 kk = *(LAS const f32x4*)(Kd + j * 64 + dkg * 4), vv = *(LAS const f32x4*)(Vl + j * 128 + dvq * 4);
#pragma unroll
        for (int i = 0; i < 4; ++i) acc[i] += kk[i] * vv; }
    float* A = WSP(float, WS_RETA) + ((size_t)(b * 4 + h) * 16 + c) * 8192;
#pragma unroll
    for (int i = 0; i < 4; ++i) *(f32x4*)(A + (dkg * 4 + i) * 128 + dvq * 4) = acc[i];
}
__device__ __forceinline__ void ret_r2_unit(Frame& F, int b, int h, int c) {
    UNIT_IDS(); const int r32 = lane & 31, hi = lane >> 5;
    LAS char* L = (LAS char*)F.lds;
    LAS float* stats = (LAS float*)(L + 65536);
    const bf16* QA = WSP(const bf16, WS_QA); const bf16* KA = WSP(const bf16, WS_KA); const bf16* VA = WSP(const bf16, WS_VA);
    const size_t tok0 = (size_t)b * 2048 + 128 * c; const float l2g = ret_log2g(h);
#pragma unroll
    for (int t = 0; t < 2; ++t) {
        at::st_slot(L + 8192 * t, *(const u32x4*)(KA + (tok0 + 64 * t + lane) * 256 + h * 64 + wid * 8), wid, lane);
#pragma unroll
        for (int i = 0; i < 2; ++i) { const int pid = tid + 512 * i, row = pid >> 4, q = pid & 15;
            *(LAS u32x4*)(L + 16384 + 16384 * t + (q >> 2) * 4096 + row * 64 + (q & 3) * 16) = *(const u32x4*)(VA + (tok0 + 64 * t + row) * 512 + h * 128 + q * 8); }
    }
    {
        const float* A = WSP(const float, WS_RETA) + (size_t)(b * 4 + h) * 16 * 8192; const float cd = exp2f(128.f * l2g);
        f32x4 s[4];
#pragma unroll
        for (int i = 0; i < 4; ++i) s[i] = (f32x4){0.f, 0.f, 0.f, 0.f};
        for (int cc = 0; cc < c; ++cc) {
#pragma unroll
            for (int i = 0; i < 4; ++i) s[i] = s[i] * cd + *(const f32x4*)(A + (size_t)cc * 8192 + 4 * tid + 2048 * i); }
#pragma unroll
        for (int i = 0; i < 4; ++i) { const int e = 4 * tid + 2048 * i, dk = e >> 7, dv = e & 127;
            u32x2 w; w.x = cvt_pk_bf16(s[i][0], s[i][1]); w.y = cvt_pk_bf16(s[i][2], s[i][3]);
            *(LAS u32x2*)(L + 49152 + (dv >> 5) * 4096 + dk * 64 + (dv & 31) * 2) = w; }
        if (c == 15) {
#pragma unroll
            for (int i = 0; i < 4; ++i) { const f32x4 fin = s[i] * cd + *(const f32x4*)(A + (size_t)15 * 8192 + 4 * tid + 2048 * i);
                *(f32x4*)(F.out + O_RETP + (size_t)(b * 4 + h) * 8192 + 4 * tid + 2048 * i) = fin; } }
    }
    __syncthreads();
    const int wq = wid & 3, dvh = wid >> 2, i_row = 32 * wq + r32;
    const int voff = at::vlane_off(lane);
    f32x16 o[2];
#pragma unroll
    for (int r = 0; r < 16; ++r) { o[0][r] = 0.f; o[1][r] = 0.f; }
    const bf16* qrow = QA + (tok0 + i_row) * 256 + h * 64;
    {
        const float qd = exp2f((float)(i_row + 1) * l2g);
        bf16x8 pa[4];
#pragma unroll
        for (int ks = 0; ks < 4; ++ks) {
            const u32x2 lo2 = *(const u32x2*)(qrow + 16 * ks + 4 * hi), hi2 = *(const u32x2*)(qrow + 16 * ks + 8 + 4 * hi);
            u32x4 w; w.x = cvt_pk_bf16(__uint_as_float(lo2.x << 16) * qd, __uint_as_float(lo2.x & 0xffff0000u) * qd); w.y = cvt_pk_bf16(__uint_as_float(lo2.y << 16) * qd, __uint_as_float(lo2.y & 0xffff0000u) * qd);
            w.z = cvt_pk_bf16(__uint_as_float(hi2.x << 16) * qd, __uint_as_float(hi2.x & 0xffff0000u) * qd); w.w = cvt_pk_bf16(__uint_as_float(hi2.y << 16) * qd, __uint_as_float(hi2.y & 0xffff0000u) * qd);
            pa[ks] = __builtin_bit_cast(bf16x8, w); }
        at::pv(o, L + 49152 + dvh * 8192 + voff, pa);
    }
    bf16x8 qr[4];
#pragma unroll
    for (int d0 = 0; d0 < 4; ++d0) qr[d0] = *(const bf16x8*)(qrow + d0 * 16 + hi * 8);
#pragma unroll
    for (int t = 0; t < 2; ++t) {
        if (64 * t <= 32 * wq + 31) {
            f32x16 p0, p1; at::qkt(p0, p1, L + 8192 * t, qr, r32, hi);
#pragma unroll
            for (int r = 0; r < 16; ++r) { const int j0 = 64 * t + at::crow(r, hi), j1 = j0 + 32;
                p0[r] = (i_row >= j0) ? p0[r] * exp2f((float)(i_row - j0) * l2g) : 0.f;
                p1[r] = (i_row >= j1) ? p1[r] * exp2f((float)(i_row - j1) * l2g) : 0.f; }
            bf16x8 pa[4]; at::pack_p(pa, p0, p1);
            at::pv(o, L + 16384 + 16384 * t + dvh * 8192 + voff, pa);
        }
    }
    float sm[16], sq[16];
#pragma unroll
    for (int r = 0; r < 16; ++r) { sm[r] = o[0][r] + o[1][r]; sq[r] = o[0][r] * o[0][r] + o[1][r] * o[1][r]; }
#pragma unroll
    for (int r = 0; r < 16; ++r) {
#pragma unroll
        for (int off = 1; off < 32; off <<= 1) { sm[r] += __shfl_xor(sm[r], off); sq[r] += __shfl_xor(sq[r], off); }
        if (r32 == 0) { stats[(wid * 32 + at::crow(r, hi)) * 2] = sm[r]; stats[(wid * 32 + at::crow(r, hi)) * 2 + 1] = sq[r]; } }
    __syncthreads();
    const float* gn = F.in[11]; const bf16* ZA = WSP(const bf16, WS_ZA); bf16* MIX = WSP(bf16, WS_MIX);
#pragma unroll
    for (int r = 0; r < 16; ++r) { const int row = at::crow(r, hi); const int pw = wid ^ 4;
        const float s1 = sm[r] + stats[(pw * 32 + row) * 2], s2 = sq[r] + stats[(pw * 32 + row) * 2 + 1];
        const float mu = s1 * (1.f / 128.f), var = s2 * (1.f / 128.f) - mu * mu, rstd = 1.f / sqrtf(var + 1e-6f);
        const size_t tok = tok0 + 32 * wq + row;
#pragma unroll
        for (int d0 = 0; d0 < 2; ++d0) { const int ch = h * 128 + 64 * dvh + 32 * d0 + r32;
            const float y = (o[d0][r] - mu) * rstd * gn[ch] * siluf_(bf2f(ZA[tok * 512 + ch]));
            MIX[tok * 1024 + ch] = (bf16)(cvt_pk_bf16(y, 0.f) & 0xffffu); } }
}
__device__ __forceinline__ void ret_sample_unit(Frame& F, int b, int h) {
    UNIT_IDS(); LAS char* L = (LAS char*)F.lds;
    LAS float* part = (LAS float*)L; LAS float* ql = (LAS float*)(L + 65536); LAS float* kl = (LAS float*)(L + 67584); LAS float* vl = (LAS float*)(L + 69632); LAS float* ol = (LAS float*)(L + 73728);
    const bf16* QA = WSP(const bf16, WS_QA); const bf16* KA = WSP(const bf16, WS_KA); const bf16* VA = WSP(const bf16, WS_VA);
    const size_t tok0 = (size_t)TP + b * 8; const float l2g = ret_log2g(h);
    { const int i = tid >> 6, d = tid & 63; ql[i * 64 + d] = bf2f(QA[(tok0 + i) * 256 + h * 64 + d]); kl[i * 64 + d] = bf2f(KA[(tok0 + i) * 256 + h * 64 + d]); }
    for (int p = tid; p < 8 * 128; p += 512) { const int i = p >> 7, d = p & 127; vl[p] = bf2f(VA[(tok0 + i) * 512 + h * 128 + d]); }
    __syncthreads();
    const int dvq = tid & 31, dkg = tid >> 5;
    const float* S0 = F.in[4] + (size_t)(b * 4 + h) * 8192; float* S1 = F.out + O_RETS + (size_t)(b * 4 + h) * 8192;
    f32x4 s[4];
#pragma unroll
    for (int i = 0; i < 4; ++i) s[i] = __builtin_nontemporal_load((const f32x4*)(S0 + (dkg * 4 + i) * 128 + dvq * 4));
#pragma unroll
    for (int t = 0; t < 8; ++t) { const float qd = exp2f((float)(t + 1) * l2g); f32x4 a = {0.f, 0.f, 0.f, 0.f};
#pragma unroll
        for (int i = 0; i < 4; ++i) a += (ql[t * 64 + dkg * 4 + i] * qd) * s[i];
        *(LAS f32x4*)(part + (dkg * 8 + t) * 128 + dvq * 4) = a; }
    const float cd = exp2f(8.f * l2g);
#pragma unroll
    for (int i = 0; i < 4; ++i) { f32x4 n = s[i] * cd;
#pragma unroll
        for (int j = 0; j < 8; ++j) n += (kl[j * 64 + dkg * 4 + i] * exp2f((float)(7 - j) * l2g)) * *(LAS const f32x4*)(vl + j * 128 + dvq * 4);
        *(f32x4*)(S1 + (dkg * 4 + i) * 128 + dvq * 4) = n; }
    __syncthreads();
    {
        const int t = wid;
        float o0 = 0.f, o1 = 0.f;
#pragma unroll
        for (int gq = 0; gq < 16; ++gq) { o0 += part[(gq * 8 + t) * 128 + lane]; o1 += part[(gq * 8 + t) * 128 + 64 + lane]; }
        for (int j = 0; j <= t; ++j) { float d = 0.f;
#pragma unroll 8
            for (int k = 0; k < 64; ++k) d += ql[t * 64 + k] * kl[j * 64 + k];
            d *= exp2f((float)(t - j) * l2g); o0 += d * vl[j * 128 + lane]; o1 += d * vl[j * 128 + 64 + lane]; }
        const float mu = wave_sum(o0 + o1) * (1.f / 128.f); const float var = wave_sum(o0 * o0 + o1 * o1) * (1.f / 128.f) - mu * mu, rstd = 1.f / sqrtf(var + 1e-6f);
        const float* gn = F.in[11]; const bf16* ZA = WSP(const bf16, WS_ZA); bf16* MIX = WSP(bf16, WS_MIX); const size_t tok = tok0 + t;
        const int c0 = h * 128 + lane, c1 = c0 + 64;
        const float y0 = (o0 - mu) * rstd * gn[c0] * siluf_(bf2f(ZA[tok * 512 + c0])), y1 = (o1 - mu) * rstd * gn[c1] * siluf_(bf2f(ZA[tok * 512 + c1]));
        MIX[tok * 1024 + c0] = (bf16)(cvt_pk_bf16(y0, 0.f) & 0xffffu); MIX[tok * 1024 + c1] = (bf16)(cvt_pk_bf16(y1, 0.f) & 0xffffu);
        (void)ol;
    }
}

__device__ __forceinline__ void cmp_unit(Frame& F, int b, int c, bool samp) {
    UNIT_IDS(); const int r32 = lane & 31, hi = lane >> 5;
    LAS char* L = (LAS char*)F.lds;
    const int g = wid >> 2, m = 32 * (wid & 3) + r32;
    const bf16* WCT = WSP(const bf16, WS_WCT) + (size_t)c * 131072;
    const float* srcf = nullptr; const bf16* srcb = nullptr;
    if (samp) { const int page = F.ptab[b * 16 + (m >> 3)]; srcf = F.in[2] + ((size_t)page * 128 + 16 * (m & 7)) * 512 + c * 128 + g * 64 + 8 * hi; }
    else srcb = WSP(const bf16, WS_KXP) + ((size_t)(c * 8 + b) * 2 + g) * 131072 + (size_t)(16 * m) * 64 + 8 * hi;
    f32x16 acc[4];
#pragma unroll
    for (int j = 0; j < 4; ++j)
#pragma unroll
        for (int r = 0; r < 16; ++r) acc[j][r] = 0.f;
#pragma unroll 1
    for (int kc = 0; kc < 2; ++kc) {
        __syncthreads();
#pragma unroll
        for (int i = 0; i < 16; ++i) { const int pid = tid + 512 * i, n = pid >> 6, q = pid & 63;
            *(LAS u32x4*)(L + n * 1040 + q * 16) = *(const u32x4*)(WCT + (size_t)n * 1024 + 512 * kc + q * 8); }
        __syncthreads();
#pragma unroll 4
        for (int ks = 0; ks < 32; ++ks) {
            const int kg = 512 * kc + 16 * ks, l = kg >> 6, d0 = kg & 63;
            bf16x8 a;
            if (samp) { const f32x4 x0 = __builtin_nontemporal_load((const f32x4*)(srcf + (size_t)l * 512 + d0)), x1 = __builtin_nontemporal_load((const f32x4*)(srcf + (size_t)l * 512 + d0 + 4));
                u32x4 w; w.x = cvt_pk_bf16(x0[0], x0[1]); w.y = cvt_pk_bf16(x0[2], x0[3]); w.z = cvt_pk_bf16(x1[0], x1[1]); w.w = cvt_pk_bf16(x1[2], x1[3]); a = __builtin_bit_cast(bf16x8, w); }
            else a = *(const bf16x8*)(srcb + l * 64 + d0);
#pragma unroll
            for (int j = 0; j < 4; ++j) { const bf16x8 bf = *(LAS const bf16x8*)(L + (32 * j + r32) * 1040 + (16 * ks + 8 * hi) * 2); acc[j] = at::mfma32(a, bf, acc[j]); }
        }
    }
    __syncthreads();
    LAS float* P1 = (LAS float*)L;
#pragma unroll
    for (int j = 2; j < 4; ++j)
#pragma unroll
        for (int r = 0; r < 16; ++r) { const int mm = 32 * (wid & 3) + at::crow(r, hi); P1[(g * 128 + mm) * 64 + 32 * (j - 2) + r32] = acc[j][r]; }
    __syncthreads();
    const float* cc = WSP(const float, WS_CCONST) + c * 64;
    bf16* dst = samp ? WSP(bf16, WS_CKS) + ((size_t)(c * 128 + b) * 2 + g) * 8192 : WSP(bf16, WS_CKP) + ((size_t)(c * 8 + b) * 2 + g) * 8192;
#pragma unroll
    for (int j = 0; j < 2; ++j)
#pragma unroll
        for (int r = 0; r < 16; ++r) { const int n = 32 * (wid & 3) + at::crow(r, hi), e = 32 * j + r32;
            const float v = n < 127 ? acc[j][r] + P1[(g * 128 + n + 1) * 64 + e] + cc[e] : 0.f;
            dst[n * 64 + e] = (bf16)(cvt_pk_bf16(v, 0.f) & 0xffffu); }
}
__device__ __forceinline__ f32x4 mfma16(bf16x8 a, bf16x8 b, f32x4 c) { return __builtin_amdgcn_mfma_f32_16x16x32_bf16(a, b, c, 0, 0, 0); }
__device__ __forceinline__ float gelu_tanh(float x) { const float u = 0.7978845608028654f * (x + 0.044715f * x * x * x); const float e = __expf(2.f * u); const float th = 1.f - 2.f / (e + 1.f); return 0.5f * x * (1.f + th); }
__device__ __forceinline__ void s5_unit(Frame& F, int g, int b, bool samp) {
    UNIT_IDS(); const int fr = lane & 15, fq = lane >> 4;
    LAS char* L = (LAS char*)F.lds; LAS char* UL = L; LAS char* LOC = L + 67584;
    const bf16* U = WSP(const bf16, WS_U) + (size_t)g * TT * 16;
    if (!samp) { const bf16* src = U + (size_t)b * 2048 * 16;
#pragma unroll
        for (int i = 0; i < 8; ++i) { const int pid = tid + 512 * i, m = pid >> 5, q = pid & 31; *(LAS u32x4*)(UL + m * 528 + q * 16) = *(const u32x4*)(src + (size_t)pid * 8); } }
    else { const bf16* src = U + (size_t)TP * 16;
#pragma unroll
        for (int i = 0; i < 8; ++i) { const int pid = tid + 512 * i, m = pid >> 5, q = pid & 31; u32x4 v = {0u, 0u, 0u, 0u}; if (q >= 16) v = *(const u32x4*)(src + (size_t)m * 128 + (q - 16) * 8); *(LAS u32x4*)(UL + m * 528 + q * 16) = v; } }
    __syncthreads();
    {
        const bf16* BST = WSP(const bf16, WS_BST) + (size_t)g * 128 * 256 + (size_t)(16 * wid + fr) * 256 + 8 * fq;
        bf16x8 bfr[8];
#pragma unroll
        for (int ks = 0; ks < 8; ++ks) bfr[ks] = *(const bf16x8*)(BST + 32 * ks);
#pragma unroll 2
        for (int mt = 0; mt < 8; ++mt) { f32x4 acc = {0.f, 0.f, 0.f, 0.f};
#pragma unroll
            for (int ks = 0; ks < 8; ++ks) { const bf16x8 a = *(LAS const bf16x8*)(UL + (16 * mt + fr) * 528 + (32 * ks + 8 * fq) * 2); acc = mfma16(a, bfr[ks], acc); }
#pragma unroll
            for (int r = 0; r < 4; ++r) *(LAS float*)(LOC + (16 * mt + 4 * fq + r) * 528 + (16 * wid + fr) * 4) = acc[r]; }
    }
    __syncthreads();
    if (!samp) {
        if (wid == 0) { const float ar = WSP(const float, WS_L16)[(g * 64 + lane) * 2], ai = WSP(const float, WS_L16)[(g * 64 + lane) * 2 + 1];
            float xr = 0.f, xi = 0.f;
            for (int m = 0; m < 128; ++m) { const float lr = *(LAS const float*)(LOC + m * 528 + lane * 4), li = *(LAS const float*)(LOC + m * 528 + 256 + lane * 4);
                __builtin_amdgcn_s_waitcnt(0xc07f);
                *(LAS bf16*)(LOC + m * 528 + lane * 2) = (bf16)(cvt_pk_bf16(xr, 0.f) & 0xffffu); *(LAS bf16*)(LOC + m * 528 + 128 + lane * 2) = (bf16)(cvt_pk_bf16(xi, 0.f) & 0xffffu);
                const float nr = ar * xr - ai * xi + lr, ni = ar * xi + ai * xr + li; xr = nr; xi = ni; }
            F.out[O_SREP + (size_t)(b * 64 + g) * 64 + lane] = xr; F.out[O_SIMP + (size_t)(b * 64 + g) * 64 + lane] = xi; }
    } else {
        const float ar = WSP(const float, WS_L16)[(g * 64 + lane) * 2], ai = WSP(const float, WS_L16)[(g * 64 + lane) * 2 + 1];
        const float br = WSP(const float, WS_L8I)[(g * 64 + lane) * 2], bi = WSP(const float, WS_L8I)[(g * 64 + lane) * 2 + 1];
        for (int m = wid; m < 128; m += 8) { const float lr = *(LAS const float*)(LOC + m * 528 + lane * 4), li = *(LAS const float*)(LOC + m * 528 + 256 + lane * 4);
            const float sr = F.in[5][(size_t)(m * 64 + g) * 64 + lane], si = F.in[6][(size_t)(m * 64 + g) * 64 + lane];
            const float xr = br * sr - bi * si, xi = br * si + bi * sr;
            __builtin_amdgcn_s_waitcnt(0xc07f);
            *(LAS bf16*)(LOC + m * 528 + lane * 2) = (bf16)(cvt_pk_bf16(xr, 0.f) & 0xffffu); *(LAS bf16*)(LOC + m * 528 + 128 + lane * 2) = (bf16)(cvt_pk_bf16(xi, 0.f) & 0xffffu);
            F.out[O_SRES + (size_t)(m * 64 + g) * 64 + lane] = ar * xr - ai * xi + lr; F.out[O_SIMS + (size_t)(m * 64 + g) * 64 + lane] = ar * xi + ai * xr + li; }
    }
    __syncthreads();
    if (!samp || wid >= 4) {
        const bf16* MT = WSP(const bf16, WS_MT) + (size_t)g * 256 * 256 + (size_t)(32 * wid + fr) * 256 + 8 * fq;
        const bf16* CXT = WSP(const bf16, WS_CXT) + (size_t)g * 256 * 128 + (size_t)(32 * wid + fr) * 128 + 8 * fq;
        bf16x8 bm[2][8], bc[2][4];
#pragma unroll
        for (int nt = 0; nt < 2; ++nt) {
#pragma unroll
            for (int ks = 0; ks < 8; ++ks) bm[nt][ks] = *(const bf16x8*)(MT + (size_t)nt * 16 * 256 + 32 * ks);
#pragma unroll
            for (int ks = 0; ks < 4; ++ks) bc[nt][ks] = *(const bf16x8*)(CXT + (size_t)nt * 16 * 128 + 32 * ks); }
        bf16* YG = WSP(bf16, WS_YG);
#pragma unroll 1
        for (int mt = 0; mt < 8; ++mt) { f32x4 acc[2] = {{0.f, 0.f, 0.f, 0.f}, {0.f, 0.f, 0.f, 0.f}};
#pragma unroll
            for (int ks = 0; ks < 8; ++ks) { const bf16x8 a = *(LAS const bf16x8*)(UL + (16 * mt + fr) * 528 + (32 * ks + 8 * fq) * 2); acc[0] = mfma16(a, bm[0][ks], acc[0]); acc[1] = mfma16(a, bm[1][ks], acc[1]); }
#pragma unroll
            for (int ks = 0; ks < 4; ++ks) { const bf16x8 a = *(LAS const bf16x8*)(LOC + (16 * mt + fr) * 528 + (32 * ks + 8 * fq) * 2); acc[0] = mfma16(a, bc[0][ks], acc[0]); acc[1] = mfma16(a, bc[1][ks], acc[1]); }
#pragma unroll
            for (int nt = 0; nt < 2; ++nt)
#pragma unroll
                for (int r = 0; r < 4; ++r) { const int m = 16 * mt + 4 * fq + r, t = 2 * wid + nt;
                    const size_t tok = samp ? (size_t)TP + 8 * m + (t - 8) : (size_t)b * 2048 + 16 * m + t;
                    YG[tok * 1024 + g * 16 + fr] = (bf16)(cvt_pk_bf16(gelu_tanh(acc[nt][r]), 0.f) & 0xffffu); }
        }
    }
}
__device__ __forceinline__ void s5_tables(Frame& F, int g) {
    const int tid = F.tid; LAS char* L = (LAS char*)F.lds;
    LAS float* POW = (LAS float*)L;
    LAS float* BB = (LAS float*)(L + 8704);
    LAS float* KT = (LAS float*)(L + 16896);
    LAS float* CC = (LAS float*)(L + 33280);
    const float* lre = F.in[18] + g * 64; const float* lim = F.in[19] + g * 64;
    const float dt = expf(F.in[25][g]);
    for (int p = tid; p < 64; p += 512) {
        const float lr = lre[p], li = lim[p];
        for (int tau = 0; tau <= 16; ++tau) { const float mg = expf((float)tau * lr * dt); float sn, cs; sincos_d((double)tau * (double)(li * dt), sn, cs); POW[(tau * 64 + p) * 2] = mg * cs; POW[(tau * 64 + p) * 2 + 1] = mg * sn; }
        { const float mg = expf(-8.f * lr * dt); float sn, cs; sincos_d(8.0 * (double)(li * dt), sn, cs); WSP(float, WS_L8I)[(g * 64 + p) * 2] = mg * cs; WSP(float, WS_L8I)[(g * 64 + p) * 2 + 1] = -mg * sn; }
    }
    __syncthreads();
    for (int e = tid; e < 1024; e += 512) { const int p = e >> 4, c = e & 15;
        const float lr = lre[p], li = lim[p], abr = POW[(64 + p) * 2], abi = POW[(64 + p) * 2 + 1], den = lr * lr + li * li, nr = abr - 1.f;
        const float fre = (nr * lr + abi * li) / den, fim = (abi * lr - nr * li) / den;
        const float br = F.in[20][(size_t)(g * 64 + p) * 16 + c], bi = F.in[21][(size_t)(g * 64 + p) * 16 + c];
        BB[e * 2] = fre * br - fim * bi; BB[e * 2 + 1] = fre * bi + fim * br;
        CC[(c * 64 + p) * 2] = F.in[22][(size_t)(g * 16 + c) * 64 + p]; CC[(c * 64 + p) * 2 + 1] = F.in[23][(size_t)(g * 16 + c) * 64 + p]; }
    if (tid < 64) { WSP(float, WS_L16)[(g * 64 + tid) * 2] = POW[(16 * 64 + tid) * 2]; WSP(float, WS_L16)[(g * 64 + tid) * 2 + 1] = POW[(16 * 64 + tid) * 2 + 1]; }
    __syncthreads();
    for (int e = tid; e < 4096; e += 512) { const int tau = e >> 8, c = (e >> 4) & 15, c2 = e & 15; float s = 0.f;
        for (int p = 0; p < 64; ++p) { const float cr = CC[(c * 64 + p) * 2], ci = CC[(c * 64 + p) * 2 + 1], pr = POW[(tau * 64 + p) * 2], pi = POW[(tau * 64 + p) * 2 + 1];
            const float wr = cr * pr - ci * pi, wi = cr * pi + ci * pr; s += wr * BB[(p * 16 + c2) * 2] - wi * BB[(p * 16 + c2) * 2 + 1]; }
        if (tau == 0 && c == c2) s += F.in[24][g * 16 + c];
        KT[e] = s; }
    __syncthreads();
    bf16* MT = WSP(bf16, WS_MT) + (size_t)g * 65536; bf16* BST = WSP(bf16, WS_BST) + (size_t)g * 32768; bf16* CXT = WSP(bf16, WS_CXT) + (size_t)g * 32768;
    for (int e = tid; e < 65536; e += 512) { const int n = e >> 8, k = e & 255, t = n >> 4, c = n & 15, s = k >> 4, c2 = k & 15;
        MT[e] = (bf16)(cvt_pk_bf16(t >= s ? KT[((t - s) * 16 + c) * 16 + c2] : 0.f, 0.f) & 0xffffu); }
    for (int e = tid; e < 32768; e += 512) { const int n = e >> 8, k = e & 255, p = n & 63, s = k >> 4, c2 = k & 15;
        const float pr = POW[((15 - s) * 64 + p) * 2], pi = POW[((15 - s) * 64 + p) * 2 + 1], br = BB[(p * 16 + c2) * 2], bi = BB[(p * 16 + c2) * 2 + 1];
        BST[e] = (bf16)(cvt_pk_bf16(n < 64 ? pr * br - pi * bi : pr * bi + pi * br, 0.f) & 0xffffu); }
    for (int e = tid; e < 32768; e += 512) { const int n = e >> 7, k = e & 127, t = n >> 4, c = n & 15, p = k & 63;
        const float cr = CC[(c * 64 + p) * 2], ci = CC[(c * 64 + p) * 2 + 1], pr = POW[((t + 1) * 64 + p) * 2], pi = POW[((t + 1) * 64 + p) * 2 + 1];
        CXT[e] = (bf16)(cvt_pk_bf16(k < 64 ? cr * pr - ci * pi : -(cr * pi + ci * pr), 0.f) & 0xffffu); }
    __syncthreads();
}
#define XB_TMO      128
#define XB_XCNT(j)  (256  + 64 * (j))
#define XB_XSUB(j)  (1280 + 64 * (j))
#define XB_XGEN(j)  (2304 + 64 * (j))
#define XB_TOP      3328
#define XB_TOPGEN   3392
#define XCD_BAR_WORDS 3456
#define XB_SPIN_CAP (1u << 18)
__device__ __forceinline__ unsigned xb_ld(unsigned* p)              { return __hip_atomic_load(p, __ATOMIC_RELAXED, __HIP_MEMORY_SCOPE_AGENT); }
__device__ __forceinline__ unsigned xb_add(unsigned* p, unsigned v) { return __hip_atomic_fetch_add(p, v, __ATOMIC_RELAXED, __HIP_MEMORY_SCOPE_AGENT); }
__device__ __forceinline__ unsigned xb_xcc_id() { return (unsigned)__builtin_amdgcn_s_getreg((3 << 11) | 20) & 0xFu; }
#define XB_SPIN(cond, bar) do { unsigned _sp = 0; while (cond) { __builtin_amdgcn_s_sleep(1); \
    if ((++_sp & 255u) == 0u) { if (xb_ld(&(bar)[XB_TMO])) break; if (_sp > XB_SPIN_CAP) { atomicAdd(&(bar)[XB_TMO], 1u); break; } } } } while (0)
struct XcdBarrier { unsigned* bar; unsigned x; volatile LAS unsigned* st; };
__device__ __forceinline__ XcdBarrier xcd_barrier_post(unsigned* bar, volatile LAS unsigned* st) {
    XcdBarrier b; b.bar = bar; b.x = xb_xcc_id(); b.st = st;
    if (threadIdx.x == 0) (void)xb_add(&bar[XB_XCNT(b.x)], 1u);
    return b;
}
__device__ __forceinline__ void xcd_barrier_complete(unsigned* bar, unsigned x, unsigned& nloc, unsigned& nx) {
    const unsigned G = gridDim.x * gridDim.y * gridDim.z;
    unsigned sum, cnt, mine, sp = 0u;
    for (;;) {
        sum = 0u; cnt = 0u; mine = 0u;
#pragma unroll
        for (unsigned j = 0; j < 16; ++j) { const unsigned c = xb_ld(&bar[XB_XCNT(j)]); sum += c; cnt += (c > 0u) ? 1u : 0u; mine = (j == x) ? c : mine; }
        if (sum == G) break;
        __builtin_amdgcn_s_sleep(1);
        if ((++sp & 255u) == 0u) { if (xb_ld(&bar[XB_TMO])) break; if (sp > XB_SPIN_CAP) { atomicAdd(&bar[XB_TMO], 1u); break; } }
    }
    nloc = mine > 0u ? mine : 1u; nx = cnt > 0u ? cnt : 1u;
}
__device__ __forceinline__ void xcd_barrier(const XcdBarrier& b) {
    asm volatile("s_waitcnt vmcnt(0)" ::: "memory");
    __syncthreads();
    if (threadIdx.x == 0) {
        unsigned* bar = b.bar;
        __builtin_amdgcn_s_waitcnt(0);
        unsigned nloc = b.st[0], nx = b.st[1];
        if (nloc == 0u) { xcd_barrier_complete(bar, b.x, nloc, nx); b.st[0] = nloc; b.st[1] = nx; }
        const unsigned old = xb_add(&bar[XB_XSUB(b.x)], 1u);
        const unsigned gen = old / nloc;
        if (old + 1u == (gen + 1u) * nloc) {
            __builtin_amdgcn_fence(__ATOMIC_RELEASE, "agent");
            asm volatile("s_waitcnt vmcnt(0)" ::: "memory");
            const unsigned og = xb_add(&bar[XB_TOP], 1u);
            const unsigned tg = og / nx;
            if (og + 1u == (tg + 1u) * nx) xb_add(&bar[XB_TOPGEN], 1u);
            else XB_SPIN(xb_ld(&bar[XB_TOPGEN]) == tg, bar);
            __builtin_amdgcn_fence(__ATOMIC_ACQUIRE, "agent");
            xb_add(&bar[XB_XGEN(b.x)], 1u);
            asm volatile("s_waitcnt vmcnt(0)" ::: "memory");
        } else {
            XB_SPIN(xb_ld(&bar[XB_XGEN(b.x)]) == gen, bar);
            __builtin_amdgcn_fence(__ATOMIC_ACQUIRE, "agent");
            asm volatile("s_waitcnt vmcnt(0)" ::: "memory");
        }
    }
    __syncthreads();
}

__device__ __forceinline__ int l0_src_col(int np) { const int pn = np >> 8, bj = (np >> 7) & 1, wc = (np >> 5) & 3, j = np & 31, rc = 256 * pn + 64 * wc + 32 * bj + j;
    return rc < 2816 ? rc : rc < 3328 ? rc + 24 : rc < 3352 ? rc - 3328 + 2816 : -1; }
__device__ __forceinline__ void p0_transpose_item(const float* W, const float* W2, int K, int N, bf16* WT, int nblk, int kind, const float* gain, LAS float* scr, int item, int lane) {
    const int kb = item / nblk, nb = item % nblk, k0 = 64 * kb, n0 = 32 * nb;
    const int np = n0 + (lane & 31); int sc = np; const float* Ws = W;
    if (kind == 1) sc = l0_src_col(np);
    else if (kind == 2) { const int pn = np >> 8, bj = (np >> 7) & 1, wc = (np >> 5) & 3, j = np & 31; sc = 128 * pn + 32 * wc + j; Ws = bj ? W2 : W; }
#pragma unroll 8
    for (int i = 0; i < 32; ++i) { const int kk = 2 * i + (lane >> 5); float v = 0.f; if (sc >= 0) { v = Ws[(size_t)(k0 + kk) * N + sc]; if (gain) v *= gain[k0 + kk]; } scr[kk * 33 + (lane & 31)] = v; }
    asm volatile("s_waitcnt lgkmcnt(0)" ::: "memory");
    const int c = lane & 7;
#pragma unroll
    for (int j = 0; j < 4; ++j) { const int n = (lane >> 3) + 8 * j; const LAS float* s = scr + (8 * c) * 33 + n;
        u32x4 o; o.x = cvt_pk_bf16(s[0 * 33], s[1 * 33]); o.y = cvt_pk_bf16(s[2 * 33], s[3 * 33]); o.z = cvt_pk_bf16(s[4 * 33], s[5 * 33]); o.w = cvt_pk_bf16(s[6 * 33], s[7 * 33]);
        *(u32x4*)(WT + (size_t)(n0 + n) * K + k0 + 8 * c) = o; }
    asm volatile("s_waitcnt lgkmcnt(0)" ::: "memory");
}
__device__ __forceinline__ void p0_prologue(Frame& F) {
    const int tid = F.tid, lane = F.lane;
    if (blockIdx.x < 64) s5_tables(F, (int)blockIdx.x);
    __syncthreads();
    LAS float* scr = (LAS float*)(F.lds + F.wave * 16384);
    const int gw = (int)blockIdx.x * NWAVES + F.wave, NGW = F.G * NWAVES;
    constexpr int I0 = 16 * 112, IO0 = 16 * 32, I1 = 16 * 64, IG = 16 * 64, IO1 = 16 * 32;
    for (int it = gw; it < I0 + IO0 + I1 + IG + IO1; it += NGW) {
        int r = it;
        if (r < I0) { p0_transpose_item(F.in[9], nullptr, 1024, 3352, WSP(bf16, WS_W0T), 112, 1, F.in[8], scr, r, lane); continue; } r -= I0;
        if (r < IO0) { p0_transpose_item(F.in[10], nullptr, 1024, 1024, WSP(bf16, WS_WO0T), 32, 0, nullptr, scr, r, lane); continue; } r -= IO0;
        if (r < I1) { p0_transpose_item(F.in[17], nullptr, 1024, 2048, WSP(bf16, WS_W1T), 64, 0, F.in[16], scr, r, lane); continue; } r -= I1;
        if (r < IG) { p0_transpose_item(F.in[26], F.in[27], 1024, 1024, WSP(bf16, WS_WGT), 64, 2, nullptr, scr, r, lane); continue; } r -= IG;
        p0_transpose_item(F.in[28], nullptr, 1024, 1024, WSP(bf16, WS_WO1T), 32, 0, nullptr, scr, r, lane);
    }
    for (int m = gw; m < TT; m += NGW) {
        const float* xrow = m < TP ? F.in[0] + (size_t)m * 1024 : F.in[1] + (size_t)(m - TP) * 1024;
        const f32x4* xr = (const f32x4*)xrow + lane; f32x4 v[4]; float s = 0.f;
#pragma unroll
        for (int j = 0; j < 4; ++j) { v[j] = xr[64 * j]; s += (v[j].x * v[j].x + v[j].y * v[j].y) + (v[j].z * v[j].z + v[j].w * v[j].w); }
        const float rstd = 1.f / sqrtf(wave_sum(s) * (1.f / 1024.f) + 1e-6f);
        u32x2* o8 = (u32x2*)(WSP(bf16, WS_H0) + (size_t)m * 1024) + lane;
#pragma unroll
        for (int j = 0; j < 4; ++j) { u32x2 w; w.x = cvt_pk_bf16(v[j].x * rstd, v[j].y * rstd); w.y = cvt_pk_bf16(v[j].z * rstd, v[j].w * rstd); o8[64 * j] = w; }
    }
    const int gt = (int)blockIdx.x * 512 + tid, NGT = F.G * 512;
    for (int e = gt; e < 2056 * 32; e += NGT) { const int pos = e >> 5, i = e & 31; const float inv = (float)exp(-(double)i * (9.210340371976184 / 32.0)); const float ang = (float)pos * inv; float s, c; sincos_d((double)ang, s, c);
        WSP(float, WS_ROPEC)[e] = c; WSP(float, WS_ROPES)[e] = s; }
    for (int e = gt; e < 2 * 128 * 1024; e += NGT) { const int c = e >> 17, n = (e >> 10) & 127, k = e & 1023, r = n >> 6, ee = n & 63, l = k >> 6, d = k & 63;
        WSP(bf16, WS_WCT)[e] = (bf16)(cvt_pk_bf16(F.in[15][(((size_t)c * 32 + 16 * r + l) * 64 + d) * 64 + ee], 0.f) & 0xffffu); }
    for (int o = gw; o < 128; o += NGW) { const int c = o >> 6, e = o & 63; float s = 0.f;
        for (int k = lane; k < 2048; k += 64) s += F.in[14][(size_t)c * 2048 + k] * F.in[15][((size_t)c * 2048 + k) * 64 + e];
        s = wave_sum(s); if (lane == 0) WSP(float, WS_CCONST)[o] = s; }
    { const f32x4* src = (const f32x4*)F.in[3]; f32x4* dst = (f32x4*)(F.out + O_WINS);
      for (int e = gt; e < 128 * 504 * 64; e += NGT) { const int bb = e / (504 * 64), rem = e - bb * (504 * 64); dst[(size_t)bb * 512 * 64 + rem] = __builtin_nontemporal_load(src + (size_t)bb * 512 * 64 + 8 * 64 + rem); } }
}

constexpr int N_PHASES = 9;
#ifndef MK_N_LAUNCHES
#define MK_N_LAUNCHES 9
#endif
struct Args { const void* in[29]; float* out; unsigned char* ws; int ph_lo, ph_hi; };
__global__ void __launch_bounds__(NWAVES * 64, 2) mega_fwd(Args args) {
    extern __shared__ __attribute__((aligned(16))) unsigned char lds[];
    Frame F;
    F.lds = (LAS unsigned char*)lds; F.MISC = (volatile LAS unsigned*)(F.lds + MISC_OFF);
    F.tid = threadIdx.x; F.lane = F.tid & 63; F.wave = __builtin_amdgcn_readfirstlane(F.tid >> 6); F.G = gridDim.x;
#pragma unroll
    for (int i = 0; i < 29; ++i) F.in[i] = (const float*)args.in[i];
    F.ptab = (const int*)args.in[7]; F.out = args.out; F.ws = args.ws; F.ctl = (gu32*)(args.ws + WS_CTL);
    for (int u = F.tid; u < 128; u += NWAVES * 64) F.MISC[u] = 0u;
    __syncthreads();
    XcdBarrier bar; bar.bar = (unsigned*)(F.ctl + CW_BAR); bar.x = 0; bar.st = nullptr;
    if (MK_N_LAUNCHES == 1) bar = xcd_barrier_post((unsigned*)(F.ctl + CW_BAR), F.MISC + 8);
    const int lo = args.ph_lo, hi = args.ph_hi;
#ifdef ONLY_PHASE
#define IN(k) ((k) == ONLY_PHASE && lo <= (k) && (k) < hi)
#else
#define IN(k) (lo <= (k) && (k) < hi)
#endif
#define SEAM(k) do { if (IN(k) && IN((k) + 1)) xcd_barrier(bar); } while (0)
    LAS unsigned char* ring = F.lds;

    if (IN(0)) { p0_prologue(F);
#if defined(DUP_PHASE) && DUP_PHASE == 0
        __syncthreads(); p0_prologue(F);
#endif
    }
    SEAM(0);
    if (IN(1)) {
        pg8::Gemm g{WSP(const pg8::bf16_t, WS_H0), WSP(const pg8::bf16_t, WS_W0T), TT, 3584, 1024}; pg8::StaticOrder S; S.init(TT, 3584, F.G, (int)blockIdx.x);
        pg8::EpiL0 E{WSP(bf16, WS_QA), WSP(bf16, WS_KA), WSP(bf16, WS_VA), WSP(bf16, WS_ZA), WSP(bf16, WS_QN), WSP(bf16, WS_ZB), WSP(bf16, WS_KXP), WSP(bf16, WS_KXS), WSP(float, WS_GATES), F.out,
                     WSP(const float, WS_ROPEC), WSP(const float, WS_ROPES), F.in[12], F.in[13]};
        pg8::gemm_phase<pg8::EpiL0, pg8::StaticOrder, true, true>(ring, g, S, E);
#if defined(DUP_PHASE) && DUP_PHASE == 1
        __syncthreads(); pg8::gemm_phase<pg8::EpiL0, pg8::StaticOrder, true, true>(ring, g, S, E);
#endif
    }
    SEAM(1);
    if (IN(2)) {
#if defined(DUP_PHASE) && DUP_PHASE == 2
        for (int rep = 0; rep < 2; ++rep)
        for (;;) { const int it = wq_next(F, rep ? 4 : 0); if (it >= 256 + 16 + 512 + 512) break;
#else
        for (;;) { const int it = wq_next(F, 0); if (it >= 256 + 16 + 512 + 512) break;
#endif
            if (it < 256) cmp_unit(F, it >> 1, it & 1, true);
            else if (it < 272) cmp_unit(F, (it - 256) >> 1, (it - 256) & 1, false);
            else if (it < 784) { const int u = it - 272; ret_r1_unit(F, u >> 6, (u >> 4) & 3, u & 15); }
            else { const int u = it - 784; ret_sample_unit(F, u >> 2, u & 3); } }
    }
    SEAM(2);
    if (IN(3)) {
#if defined(DUP_PHASE) && DUP_PHASE == 3
        for (int rep = 0; rep < 2; ++rep)
        for (;;) { const int it = wq_next(F, rep ? 5 : 1); if (it >= 256 + 256 + 256 + 512) break;
#else
        for (;;) { const int it = wq_next(F, 1); if (it >= 256 + 256 + 256 + 512) break;
#endif
#if defined(DUP_PHASE) && DUP_PHASE == 3 && defined(DUP3_KIND)
            const int kmask = rep ? DUP3_KIND : 7;
#else
            const int kmask = 7;
#endif
            if (it < 256 || (it >= 512 && it < 768)) { const int u = it < 256 ? it : it - 256; const int c = 31 - (u >> 4), bg = u & 15;
                if (kmask & 1) nsa_prompt_unit(F, bg >> 1, bg & 1, c); }
            else if (it < 512) { const int u = it - 256;
                if (kmask & 2) nsa_sample_unit(F, u >> 1, u & 1); }
            else { const int u = it - 768;
                if (kmask & 4) ret_r2_unit(F, u >> 6, (u >> 4) & 3, u & 15); } }
    }
    SEAM(3);
    if (IN(4)) {
        pg8::Gemm g{WSP(const pg8::bf16_t, WS_MIX), WSP(const pg8::bf16_t, WS_WO0T), TT, 1024, 1024}; pg8::StaticOrder S; S.init(TT, 1024, F.G, (int)blockIdx.x);
        pg8::EpiOut0 E{F.in[0], F.in[1], F.out + O_Y, WSP(bf16, WS_Y0B), (float*)(F.ctl + CW_SS)};
        pg8::gemm_phase<pg8::EpiOut0, pg8::StaticOrder, true, true>(ring, g, S, E);
    }
    SEAM(4);
    if (IN(5)) {
        pg8::Gemm g{WSP(const pg8::bf16_t, WS_Y0B), WSP(const pg8::bf16_t, WS_W1T), TT, 2048, 1024}; pg8::StaticOrder S; S.init(TT, 2048, F.G, (int)blockIdx.x);
        pg8::EpiL1 E{(const float*)(F.ctl + CW_SS), WSP(bf16, WS_U), WSP(bf16, WS_Z1)};
        pg8::gemm_phase<pg8::EpiL1, pg8::StaticOrder, true, true>(ring, g, S, E);
#if defined(DUP_PHASE) && DUP_PHASE == 5
        __syncthreads(); pg8::gemm_phase<pg8::EpiL1, pg8::StaticOrder, true, true>(ring, g, S, E);
#endif
    }
    SEAM(5);
    if (IN(6)) {
#if defined(DUP_PHASE) && DUP_PHASE == 6
        for (int rep = 0; rep < 2; ++rep)
        for (;;) { const int it = wq_next(F, rep ? 6 : 2); if (it >= 576) break;
#else
        for (;;) { const int it = wq_next(F, 2); if (it >= 576) break;
#endif
            if (it < 512) s5_unit(F, it & 63, it >> 6, false); else s5_unit(F, it - 512, 0, true); }
    }
    SEAM(6);
    if (IN(7)) {
        pg8::Gemm g{WSP(const pg8::bf16_t, WS_YG), WSP(const pg8::bf16_t, WS_WGT), TT, 2048, 1024}; pg8::StaticOrder S; S.init(TT, 2048, F.G, (int)blockIdx.x);
        pg8::EpiGLU E{WSP(const bf16, WS_Z1), WSP(bf16, WS_V1)};
        pg8::gemm_phase<pg8::EpiGLU, pg8::StaticOrder, true, true>(ring, g, S, E);
#if defined(DUP_PHASE) && DUP_PHASE == 7
        __syncthreads(); pg8::gemm_phase<pg8::EpiGLU, pg8::StaticOrder, true, true>(ring, g, S, E);
#endif
    }
    SEAM(7);
    if (IN(8)) {
        pg8::Gemm g{WSP(const pg8::bf16_t, WS_V1), WSP(const pg8::bf16_t, WS_WO1T), TT, 1024, 1024}; pg8::StaticOrder S; S.init(TT, 1024, F.G, (int)blockIdx.x);
        pg8::EpiFinal E{F.out + O_Y};
        pg8::gemm_phase<pg8::EpiFinal, pg8::StaticOrder, true, true>(ring, g, S, E);
    }
#undef IN
#undef SEAM
}

extern "C" void kernel_launch(void* const* d_in, const int* in_sizes, int n_in, void* d_out, int out_size, void* d_ws, size_t ws_size, hipStream_t stream) {
    static int grid = 0;
    if (grid == 0) {
        if (n_in != 29 || out_size != (int)O_END || ws_size < WS_END) { fprintf(stderr, "kernel_launch: unexpected shapes (n_in %d, out %d, ws %zu); nothing launched\n", n_in, out_size, ws_size); grid = -1; return; }
        int dev = 0, cus = 0, per_cu = 0;
        if (hipGetDevice(&dev) != hipSuccess || hipDeviceGetAttribute(&cus, hipDeviceAttributeMultiprocessorCount, dev) != hipSuccess) { grid = -1; return; }
        if (hipFuncSetAttribute((const void*)mega_fwd, hipFuncAttributeMaxDynamicSharedMemorySize, LDS_BYTES) != hipSuccess) { fprintf(stderr, "kernel_launch: hipFuncSetAttribute failed\n"); grid = -1; return; }
        if (hipOccupancyMaxActiveBlocksPerMultiprocessor(&per_cu, (const void*)mega_fwd, NWAVES * 64, LDS_BYTES) != hipSuccess || per_cu < 1) { fprintf(stderr, "kernel_launch: occupancy query says %d\n", per_cu); per_cu = 1; }
        (void)hipGetLastError();
        grid = cus;
    }
    if (grid < 0) return;
    (void)hipMemsetAsync((char*)d_ws + WS_CTL, 0, CTL_ZERO_BYTES, stream);
    Args a{};
    for (int i = 0; i < 29; ++i) a.in[i] = d_in[i];
    a.out = (float*)d_out; a.ws = (unsigned char*)d_ws;
    if (MK_N_LAUNCHES == 1) {
        a.ph_lo = 0; a.ph_hi = N_PHASES;
        void* kargs[] = {&a};
        hipError_t e = hipLaunchCooperativeKernel((const void*)mega_fwd, dim3(grid), dim3(NWAVES * 64), kargs, LDS_BYTES, stream);
        if (e != hipSuccess) fprintf(stderr, "kernel_launch: cooperative launch failed: %s (grid %d)\n", hipGetErrorString(e), grid);
    } else {
        for (int p = 0; p < N_PHASES; ++p) { a.ph_lo = p; a.ph_hi = p + 1; hipLaunchKernelGGL(mega_fwd, dim3(grid), dim3(NWAVES * 64), LDS_BYTES, stream, a); }
    }
}
```

```cpp
#include <hip/hip_runtime.h>
#include <cstdio>
#include <cstdint>
#include <cmath>
#ifndef MK_N_LAUNCHES
#define MK_N_LAUNCHES 1
#endif
namespace pg8 {
#define PG8_LAS __attribute__((address_space(3)))
typedef unsigned short bf16_t;
typedef short bf16x8 __attribute__((ext_vector_type(8)));
typedef float f32x4 __attribute__((ext_vector_type(4)));
typedef unsigned u32x4 __attribute__((ext_vector_type(4)));
constexpr int BM = 256, BK = 64, HALF = 128, HTB = HALF * BK * 2  , STAGE_BYTES = 8 * HTB, NXCD = 8, WGM = 8;

__host__ __device__ __forceinline__ int lds_byte(int r, int c) { const int st = (r >> 4) * 2 + (c >> 5), rr = r & 15, cc = c & 31, ob = rr * 64 + cc * 2; return st * 1024 + (ob ^ (((ob >> 9) & 1) << 5)); }
__host__ __device__ __forceinline__ void stage_rc(int b, int& R, int& C) { const int st = b / 1024, sb = b % 1024, swz = sb ^ (((sb >> 9) & 1) << 5); R = (st >> 1) * 16 + swz / 64; C = (st & 1) * 32 + (swz % 64) / 2; }
__host__ __device__ __forceinline__ int perm32(int rho) { const int n = rho >> 4, i = rho & 15; return 8 * (i >> 2) + 4 * n + (i & 3); }

struct Unit { int pm, pn; };
struct Gemm { const bf16_t* A; const bf16_t* Bt; int M, N, K; };

struct StaticOrder {
    int nM, nN, nwg, G, c;
    __host__ __device__ void init(int M, int N, int G_, int c_) { nM = M / BM; nN = N / BM; nwg = nM * nN; G = G_; c = c_; }
    __host__ __device__ bool next(int i, Unit& u) const {
        const long L = (long)i * G + c; if (L >= nwg) return false;
        int wgid = (int)L; { const int q = nwg / NXCD, r = nwg % NXCD, xcd = wgid % NXCD, off = wgid / NXCD; wgid = (xcd < r ? xcd * (q + 1) : r * (q + 1) + (xcd - r) * q) + off; }
        const int nig = WGM * nN, gid = wgid / nig, fm = gid * WGM, gsz = (nM - fm) < WGM ? (nM - fm) : WGM;
        u.pm = fm + ((wgid % nig) % gsz); u.pn = (wgid % nig) / gsz; return true;
    }
    __device__ __forceinline__ void a_ready(const Unit&) const {}
    __device__ __forceinline__ void done(const Unit&) const {}
};

typedef float f32x2 __attribute__((ext_vector_type(2)));
typedef __bf16 bf16x2_t __attribute__((ext_vector_type(2)));
__device__ __forceinline__ unsigned cvt_pk_bf16(float lo, float hi) { f32x2 v = {lo, hi}; bf16x2_t b = __builtin_convertvector(v, bf16x2_t); return __builtin_bit_cast(unsigned, b); }
__device__ __forceinline__ u32x4 pack8(const float* v) { u32x4 w; w.x = cvt_pk_bf16(v[0], v[1]); w.y = cvt_pk_bf16(v[2], v[3]); w.z = cvt_pk_bf16(v[4], v[5]); w.w = cvt_pk_bf16(v[6], v[7]); return w; }
__device__ __forceinline__ float bf2f(unsigned short h) { return __uint_as_float(((unsigned)h) << 16); }
__device__ __forceinline__ void unpack8(u32x4 w, float* v) { v[0] = __uint_as_float(w.x << 16); v[1] = __uint_as_float(w.x & 0xffff0000u); v[2] = __uint_as_float(w.y << 16); v[3] = __uint_as_float(w.y & 0xffff0000u);
    v[4] = __uint_as_float(w.z << 16); v[5] = __uint_as_float(w.z & 0xffff0000u); v[6] = __uint_as_float(w.w << 16); v[7] = __uint_as_float(w.w & 0xffff0000u); }
__device__ __forceinline__ float sigmoidf_(float x) { return 1.f / (1.f + __expf(-x)); }
__device__ __forceinline__ float siluf_(float x) { return x / (1.f + __expf(-x)); }

constexpr float QSCALE = 0.125f * 1.4426950408889634f;
constexpr size_t O_Y = 0, O_RETP = 17825792, O_RETS = 18087936, O_KVP = 22282240, O_KVS = 30670848, O_WINP = 31195136, O_WINS = 32243712,
                 O_SREP = 49020928, O_SIMP = 49053696, O_SRES = 49086464, O_SIMS = 49610752, O_END = 50135040;

struct EpiL0 {
    static constexpr bool PERM = true, AFTER_DRAIN = false;
    bf16_t *QA, *KA, *VA, *ZA, *QN, *ZB, *KXP, *KXS; float *GATES, *out; const float *ropeC, *ropeS, *qnorm, *knorm;
    __device__ __forceinline__ void operator()(const f32x4 (&acc)[2][2][4][2], const Unit& u, int wr, int wc, int fr, int fq) const {
        const int pn = u.pn; const bool samp = u.pm >= 64; const int d0 = 8 * fq;
        bool do_norm = false, do_rope = false, gates = false; float scale = 1.f; const float* nw = nullptr;
        bf16_t* bdst = nullptr; int bpitch = 0, bmode = 0, fmode = 0, type = 0, g = 0;
        if (pn == 0) { do_rope = true; bdst = QA + wc * 64; bpitch = 256; }
        else if (pn == 1) { do_rope = true; scale = 0.125f; bdst = KA + wc * 64; bpitch = 256; }
        else if (pn < 4) { bdst = VA + (pn - 2) * 256 + wc * 64; bpitch = 512; }
        else if (pn < 6) { bdst = ZA + (pn - 4) * 256 + wc * 64; bpitch = 512; }
        else if (pn < 8) { do_norm = true; do_rope = true; nw = qnorm; scale = QSCALE; bdst = QN + (pn - 6) * 256 + wc * 64; bpitch = 512; }
        else if (pn < 11) { const int slot = (pn - 8) * 4 + wc; type = slot >> 1; g = slot & 1; if (!(type & 1)) { do_norm = true; do_rope = true; nw = knorm + (type >> 1) * 64; }
            bmode = 1; bpitch = 64; bdst = samp ? KXS + (size_t)type * 131072 + g * 512 : KXP + (size_t)type * 2097152 + (size_t)g * 131072; fmode = type < 4 ? 1 : 2; }
        else if (pn < 13) { bdst = ZB + (pn - 11) * 256 + wc * 64; bpitch = 512; }
        else { gates = true; }
        float nwl[8], nwh[8];
        if (do_norm) {
#pragma unroll
            for (int j = 0; j < 8; ++j) { nwl[j] = nw[d0 + j]; nwh[j] = nw[32 + d0 + j]; } }
#pragma unroll
        for (int ai = 0; ai < 2; ++ai)
#pragma unroll
            for (int m = 0; m < 4; ++m) {
                const int row = u.pm * BM + ai * HALF + wr * 64 + m * 16 + fr;
                int b, t, pos; if (!samp) { b = row >> 11; t = row & 2047; pos = t; } else { const int rs = row - 16384; b = rs >> 3; t = rs & 7; pos = 2048 + t; }
                float lo[8], hi[8];
#pragma unroll
                for (int n = 0; n < 2; ++n)
#pragma unroll
                    for (int i = 0; i < 4; ++i) { lo[4 * n + i] = acc[ai][0][m][n][i]; hi[4 * n + i] = acc[ai][1][m][n][i]; }
                if (gates) {
                    if (wc == 0 && fq < 3) {
                        f32x4 a, c;
#pragma unroll
                        for (int i = 0; i < 4; ++i) { a[i] = sigmoidf_(lo[i]); c[i] = sigmoidf_(lo[4 + i]); }
                        *(f32x4*)(GATES + (size_t)row * 24 + d0) = a; *(f32x4*)(GATES + (size_t)row * 24 + d0 + 4) = c; }
                    continue; }
                if (do_norm) {
                    float ss = 0.f;
#pragma unroll
                    for (int j = 0; j < 8; ++j) ss += lo[j] * lo[j] + hi[j] * hi[j];
                    ss += __shfl_xor(ss, 16); ss += __shfl_xor(ss, 32);
                    const float rstd = __builtin_amdgcn_rsqf(ss * (1.f / 64.f) + 1e-6f);
#pragma unroll
                    for (int j = 0; j < 8; ++j) { lo[j] *= rstd * nwl[j]; hi[j] *= rstd * nwh[j]; } }
                if (do_rope) {
                    const f32x4 c0 = *(const f32x4*)(ropeC + pos * 32 + d0), c1 = *(const f32x4*)(ropeC + pos * 32 + d0 + 4);
                    const f32x4 s0 = *(const f32x4*)(ropeS + pos * 32 + d0), s1 = *(const f32x4*)(ropeS + pos * 32 + d0 + 4);
#pragma unroll
                    for (int j = 0; j < 8; ++j) { const float c = j < 4 ? c0[j & 3] : c1[j & 3], s = j < 4 ? s0[j & 3] : s1[j & 3]; const float x1 = lo[j], x2 = hi[j]; lo[j] = x1 * c - x2 * s; hi[j] = x2 * c + x1 * s; } }
                if (fmode) {
                    float* fp = nullptr;
                    if (fmode == 1) fp = out + (samp ? O_KVS : O_KVP) + (size_t)(samp ? row - 16384 : row) * 512 + type * 128 + g * 64;
                    else if (samp) fp = out + O_WINS + ((size_t)(b * 512 + 504 + t) * 2 + (type - 4)) * 128 + g * 64;
                    else if (t >= 1536) fp = out + O_WINP + ((size_t)(b * 512 + t - 1536) * 2 + (type - 4)) * 128 + g * 64;
                    if (fp) { *(f32x4*)(fp + d0) = (f32x4){lo[0], lo[1], lo[2], lo[3]}; *(f32x4*)(fp + d0 + 4) = (f32x4){lo[4], lo[5], lo[6], lo[7]};
                              *(f32x4*)(fp + 32 + d0) = (f32x4){hi[0], hi[1], hi[2], hi[3]}; *(f32x4*)(fp + 32 + d0 + 4) = (f32x4){hi[4], hi[5], hi[6], hi[7]}; } }
                if (scale != 1.f) {
#pragma unroll
                    for (int j = 0; j < 8; ++j) { lo[j] *= scale; hi[j] *= scale; } }
                const size_t ridx = bmode ? (samp ? (size_t)(b * 16 + t) : (size_t)(b * 4096 + t)) : (size_t)row;
                bf16_t* bp = bdst + ridx * bpitch;
                *(u32x4*)(bp + d0) = pack8(lo); *(u32x4*)(bp + 32 + d0) = pack8(hi);
            }
    }
};

struct EpiOut0 {
    static constexpr bool PERM = true, AFTER_DRAIN = false;
    const float *xp, *xs; float* y; bf16_t* yb; float* ss;
    __device__ __forceinline__ void operator()(const f32x4 (&acc)[2][2][4][2], const Unit& u, int wr, int wc, int fr, int fq) const {
        const float* xb = u.pm >= 64 ? xs - (size_t)16384 * 1024 : xp;
        const int c0 = u.pn * BM + wc * 32 + 8 * fq;
#pragma unroll
        for (int ai = 0; ai < 2; ++ai)
#pragma unroll
            for (int m = 0; m < 4; ++m) {
                const int row = u.pm * BM + ai * HALF + wr * 64 + m * 16 + fr; float sq = 0.f;
#pragma unroll
                for (int bj = 0; bj < 2; ++bj) {
                    const size_t off = (size_t)row * 1024 + c0 + bj * HALF;
                    const f32x4 x0 = *(const f32x4*)(xb + off), x1 = *(const f32x4*)(xb + off + 4);
                    const f32x4 v0 = acc[ai][bj][m][0] + x0, v1 = acc[ai][bj][m][1] + x1;
                    *(f32x4*)(y + off) = v0; *(f32x4*)(y + off + 4) = v1;
                    float v[8] = {v0[0], v0[1], v0[2], v0[3], v1[0], v1[1], v1[2], v1[3]};
#pragma unroll
                    for (int j = 0; j < 8; ++j) sq += v[j] * v[j];
                    *(u32x4*)(yb + off) = pack8(v); }
                sq += __shfl_xor(sq, 16); sq += __shfl_xor(sq, 32);
                if (fq == 0) atomicAdd(ss + row, sq);
            }
    }
};

struct EpiL1 {
    static constexpr bool PERM = true, AFTER_DRAIN = false;
    const float* ss; bf16_t *U, *Z1;
    __device__ __forceinline__ void operator()(const f32x4 (&acc)[2][2][4][2], const Unit& u, int wr, int wc, int fr, int fq) const {
        const int c0 = u.pn * BM + wc * 32 + 8 * fq;
#pragma unroll
        for (int ai = 0; ai < 2; ++ai)
#pragma unroll
            for (int m = 0; m < 4; ++m) {
                const int row = u.pm * BM + ai * HALF + wr * 64 + m * 16 + fr;
                const float rstd = __builtin_amdgcn_rsqf(ss[row] * (1.f / 1024.f) + 1e-6f);
#pragma unroll
                for (int bj = 0; bj < 2; ++bj) {
                    const int c = c0 + bj * HALF; float v[8];
#pragma unroll
                    for (int i = 0; i < 4; ++i) { v[i] = acc[ai][bj][m][0][i] * rstd; v[4 + i] = acc[ai][bj][m][1][i] * rstd; }
                    bf16_t* p = c < 1024 ? U + ((size_t)(c >> 4) * 17408 + row) * 16 + (c & 15) : Z1 + (size_t)row * 1024 + (c - 1024);
                    *(u32x4*)p = pack8(v); }
            }
    }
};

struct EpiGLU {
    static constexpr bool PERM = true, AFTER_DRAIN = false;
    const bf16_t* Z1; bf16_t* V1;
    __device__ __forceinline__ void operator()(const f32x4 (&acc)[2][2][4][2], const Unit& u, int wr, int wc, int fr, int fq) const {
        const int c = u.pn * 128 + wc * 32 + 8 * fq;
#pragma unroll
        for (int ai = 0; ai < 2; ++ai)
#pragma unroll
            for (int m = 0; m < 4; ++m) {
                const int row = u.pm * BM + ai * HALF + wr * 64 + m * 16 + fr;
                float z[8]; unpack8(*(const u32x4*)(Z1 + (size_t)row * 1024 + c), z); float v[8];
#pragma unroll
                for (int i = 0; i < 4; ++i) { v[i] = acc[ai][0][m][0][i] * sigmoidf_(acc[ai][1][m][0][i]) * siluf_(z[i]); v[4 + i] = acc[ai][0][m][1][i] * sigmoidf_(acc[ai][1][m][1][i]) * siluf_(z[4 + i]); }
                *(u32x4*)(V1 + (size_t)row * 1024 + c) = pack8(v);
            }
    }
};

struct EpiFinal {
    static constexpr bool PERM = true, AFTER_DRAIN = false;
    float* y;
    __device__ __forceinline__ void operator()(const f32x4 (&acc)[2][2][4][2], const Unit& u, int wr, int wc, int fr, int fq) const {
        const int c0 = u.pn * BM + wc * 32 + 8 * fq;
#pragma unroll
        for (int ai = 0; ai < 2; ++ai)
#pragma unroll
            for (int m = 0; m < 4; ++m) {
                const int row = u.pm * BM + ai * HALF + wr * 64 + m * 16 + fr;
#pragma unroll
                for (int bj = 0; bj < 2; ++bj) { float* p = y + (size_t)row * 1024 + c0 + bj * HALF;
                    *(f32x4*)p = *(const f32x4*)p + acc[ai][bj][m][0]; *(f32x4*)(p + 4) = *(const f32x4*)(p + 4) + acc[ai][bj][m][1]; }
            }
    }
};

template <class Epi, class Sched, bool ALIGN_EPI = false, bool SP2 = false>
__device__ __forceinline__ void gemm_phase(PG8_LAS unsigned char* lds, const Gemm g, const Sched& S, const Epi& E) {
    const int tid = threadIdx.x, wid = __builtin_amdgcn_readfirstlane(tid >> 6), lane = tid & 63, wr = wid >> 2, wc = wid & 3, fr = lane & 15, fq = lane >> 4;
    const int K = g.K, nt = K / BK;
    unsigned voffA[2], voffB[2];
#pragma unroll
    for (int i = 0; i < 2; ++i) { int R, C; stage_rc(tid * 16 + i * 8192, R, C); const int Rb = Epi::PERM ? ((R & ~31) + perm32(R & 31)) : R;
        voffA[i] = (unsigned)(R * K + C) * 2u; voffB[i] = (unsigned)(Rb * K + C) * 2u; }
    const size_t kstep = (size_t)(BK * 2);
    const size_t hstep = (size_t)HALF * K * 2;
    const size_t tstep = 2 * hstep;
    const unsigned ldsw = (unsigned)wid * 1024u;
    const int aoff = lds_byte(wr * 64 + fr, fq * 8), boff = lds_byte(wc * 32 + fr, fq * 8);
#define PG8_SA(b, h) (((b) * 2 + (h)) * HTB)
#define PG8_SB(b, h) ((4 + (b) * 2 + (h)) * HTB)
#define PG8_STAGE(bufoff, gbase, voff) do { _Pragma("unroll") for (int _i = 0; _i < 2; ++_i) \
        __builtin_amdgcn_global_load_lds((const unsigned*)((const char*)(gbase) + (voff)[_i]), (PG8_LAS unsigned*)(lds + (bufoff) + ldsw + _i * 8192), 16, 0, 0); } while (0)
#define PG8_LDA(dst, b, h) do { _Pragma("unroll") for (int m = 0; m < 4; ++m) _Pragma("unroll") for (int k = 0; k < 2; ++k) dst[m][k] = *(const PG8_LAS bf16x8*)(lds + PG8_SA(b, h) + aoff + m * 2048 + k * 1024); } while (0)
#define PG8_LDB(dst, b, h) do { _Pragma("unroll") for (int n = 0; n < 2; ++n) _Pragma("unroll") for (int k = 0; k < 2; ++k) dst[n][k] = *(const PG8_LAS bf16x8*)(lds + PG8_SB(b, h) + boff + n * 2048 + k * 1024); } while (0)
#define PG8_MMA(ai, bj, At, Bt) do { __builtin_amdgcn_s_setprio(1); _Pragma("unroll") for (int m = 0; m < 4; ++m) _Pragma("unroll") for (int n = 0; n < 2; ++n) _Pragma("unroll") for (int k = 0; k < 2; ++k) \
        acc[ai][bj][m][n] = __builtin_amdgcn_mfma_f32_16x16x32_bf16(Bt[n][k], At[m][k], acc[ai][bj][m][n], 0, 0, 0); __builtin_amdgcn_s_setprio(0); } while (0)
#define PG8_WAIT_V(n) asm volatile("s_waitcnt vmcnt(" #n ")" ::: "memory")
#define PG8_WAIT_L(n) asm volatile("s_waitcnt lgkmcnt(" #n ")" ::: "memory")
#define PG8_BAR __builtin_amdgcn_s_barrier()
#define PG8_SCHED __builtin_amdgcn_sched_barrier(0)
    Unit cur, nxt; int ui = 0;
    if (!S.next(0, cur)) return;
    f32x4 acc[2][2][4][2];
#pragma unroll
    for (int a = 0; a < 2; ++a)
#pragma unroll
        for (int b = 0; b < 2; ++b)
#pragma unroll
            for (int m = 0; m < 4; ++m)
#pragma unroll
                for (int n = 0; n < 2; ++n) acc[a][b][m][n] = (f32x4){0.f, 0.f, 0.f, 0.f};
    bf16x8 At[4][2], B0[2][2], B1[2][2];
    const char* cA = (const char*)g.A + (size_t)cur.pm * tstep; const char* cB = (const char*)g.Bt + (size_t)cur.pn * tstep;
    S.a_ready(cur);
    if constexpr (SP2) {
        PG8_STAGE(PG8_SB(0, 0), cB, voffB); PG8_STAGE(PG8_SB(0, 1), cB + hstep, voffB); PG8_STAGE(PG8_SA(0, 0), cA, voffA); PG8_STAGE(PG8_SA(0, 1), cA + hstep, voffA);
        if (wr == 1) PG8_BAR;
        PG8_WAIT_V(2); PG8_BAR;
        PG8_STAGE(PG8_SB(1, 0), cB + kstep, voffB); PG8_STAGE(PG8_SA(1, 0), cA + kstep, voffA); PG8_STAGE(PG8_SB(1, 1), cB + hstep + kstep, voffB);
        PG8_WAIT_V(6); PG8_BAR;
    } else {
        PG8_STAGE(PG8_SB(0, 0), cB, voffB); PG8_STAGE(PG8_SA(0, 0), cA, voffA); PG8_STAGE(PG8_SB(0, 1), cB + hstep, voffB); PG8_STAGE(PG8_SA(0, 1), cA + hstep, voffA);
        if (wr == 1) PG8_BAR;
        PG8_WAIT_V(4); PG8_BAR;
        PG8_STAGE(PG8_SB(1, 0), cB + kstep, voffB); PG8_STAGE(PG8_SA(1, 0), cA + kstep, voffA); PG8_STAGE(PG8_SB(1, 1), cB + hstep + kstep, voffB);
        PG8_WAIT_V(6); PG8_BAR;
    }
    for (;;) {
        const bool has_next = S.next(ui + 1, nxt);
        const char* nA = has_next ? (const char*)g.A + (size_t)nxt.pm * tstep : cA; const char* nB = has_next ? (const char*)g.Bt + (size_t)nxt.pn * tstep : cB;
        for (int t = 0; t < nt; t += 2) {
            const bool last = (t == nt - 2);
            const char* a1 = cA + (size_t)(t + 1) * kstep;
            const char* a2 = last ? nA : cA + (size_t)(t + 2) * kstep; const char* b2 = last ? nB : cB + (size_t)(t + 2) * kstep;
            const char* a3 = a2 + kstep; const char* b3 = b2 + kstep;
            if (last && has_next) S.a_ready(nxt);
            if constexpr (SP2) {
            PG8_LDB(B0, 0, 0); PG8_LDB(B1, 0, 1); PG8_SCHED; PG8_LDA(At, 0, 0); PG8_STAGE(PG8_SA(1, 1), a1 + hstep, voffA);
            PG8_WAIT_V(8); PG8_WAIT_L(0); PG8_BAR; PG8_MMA(0, 0, At, B0); PG8_MMA(0, 1, At, B1); PG8_BAR; PG8_SCHED;
            PG8_LDA(At, 0, 1); PG8_STAGE(PG8_SB(0, 0), b2, voffB); PG8_STAGE(PG8_SB(0, 1), b2 + hstep, voffB); PG8_STAGE(PG8_SA(0, 0), a2, voffA);
            PG8_WAIT_V(8); PG8_WAIT_L(0); PG8_BAR; PG8_MMA(1, 0, At, B0); PG8_MMA(1, 1, At, B1); PG8_BAR; PG8_SCHED;
            PG8_LDB(B0, 1, 0); PG8_LDB(B1, 1, 1); PG8_SCHED; PG8_LDA(At, 1, 0); PG8_STAGE(PG8_SA(0, 1), a2 + hstep, voffA);
            PG8_WAIT_V(8); PG8_WAIT_L(0); PG8_BAR; PG8_MMA(0, 0, At, B0); PG8_MMA(0, 1, At, B1); PG8_BAR; PG8_SCHED;
            PG8_LDA(At, 1, 1); PG8_STAGE(PG8_SB(1, 0), b3, voffB); PG8_STAGE(PG8_SB(1, 1), b3 + hstep, voffB); PG8_STAGE(PG8_SA(1, 0), a3, voffA);
            PG8_WAIT_V(8); PG8_WAIT_L(0); PG8_BAR; PG8_MMA(1, 0, At, B0); PG8_MMA(1, 1, At, B1); PG8_BAR; PG8_SCHED;
            } else {
            PG8_LDB(B0, 0, 0); PG8_SCHED; PG8_LDA(At, 0, 0); PG8_STAGE(PG8_SA(1, 1), a1 + hstep, voffA);
            PG8_WAIT_L(8); PG8_BAR; PG8_WAIT_L(0); PG8_MMA(0, 0, At, B0); PG8_BAR; PG8_SCHED;
            PG8_LDB(B1, 0, 1); PG8_STAGE(PG8_SB(0, 0), b2, voffB);
            PG8_BAR; PG8_WAIT_L(0); PG8_MMA(0, 1, At, B1); PG8_BAR;
            PG8_LDA(At, 0, 1); PG8_STAGE(PG8_SA(0, 0), a2, voffA);
            PG8_BAR; PG8_WAIT_L(0); PG8_MMA(1, 0, At, B0); PG8_BAR; PG8_SCHED;
            PG8_STAGE(PG8_SB(0, 1), b2 + hstep, voffB);
            PG8_WAIT_V(6); PG8_BAR; PG8_MMA(1, 1, At, B1); PG8_BAR;
            PG8_LDB(B0, 1, 0); PG8_SCHED; PG8_LDA(At, 1, 0); PG8_STAGE(PG8_SA(0, 1), a2 + hstep, voffA);
            PG8_WAIT_L(8); PG8_BAR; PG8_WAIT_L(0); PG8_MMA(0, 0, At, B0); PG8_BAR; PG8_SCHED;
            PG8_LDB(B1, 1, 1); PG8_STAGE(PG8_SB(1, 0), b3, voffB);
            PG8_BAR; PG8_WAIT_L(0); PG8_MMA(0, 1, At, B1); PG8_BAR;
            PG8_LDA(At, 1, 1); PG8_STAGE(PG8_SA(1, 0), a3, voffA);
            PG8_BAR; PG8_WAIT_L(0); PG8_MMA(1, 0, At, B0); PG8_BAR; PG8_SCHED;
            PG8_STAGE(PG8_SB(1, 1), b3 + hstep, voffB);
            PG8_WAIT_V(6); PG8_BAR; PG8_MMA(1, 1, At, B1); PG8_BAR;
            }
        }
        if constexpr (ALIGN_EPI) { if (wr == 0) PG8_BAR; }
        if constexpr (!Epi::AFTER_DRAIN) { E(acc, cur, wr, wc, fr, fq); S.done(cur); }
        if (!has_next) break;
#pragma unroll
        for (int a = 0; a < 2; ++a)
#pragma unroll
            for (int b = 0; b < 2; ++b)
#pragma unroll
                for (int m = 0; m < 4; ++m)
#pragma unroll
                    for (int n = 0; n < 2; ++n) acc[a][b][m][n] = (f32x4){0.f, 0.f, 0.f, 0.f};
        cur = nxt; cA = nA; cB = nB; ++ui;
        if constexpr (ALIGN_EPI) { if (wr == 1) PG8_BAR; }
    }
    PG8_WAIT_V(0);
    if constexpr (!ALIGN_EPI) { if (wr == 0) PG8_BAR; }
    PG8_BAR;
    if constexpr (Epi::AFTER_DRAIN) { E.fused(acc, cur, wr, wc, fr, fq, lds, wid, lane); S.done(cur); }
#undef PG8_SA
#undef PG8_SB
#undef PG8_STAGE
#undef PG8_LDA
#undef PG8_LDB
#undef PG8_MMA
#undef PG8_WAIT_V
#undef PG8_WAIT_L
#undef PG8_BAR
#undef PG8_SCHED
}
}
#define LAS __attribute__((address_space(3)))
#define GAS __attribute__((address_space(1)))
typedef unsigned short bf16;
typedef short bf16x8 __attribute__((ext_vector_type(8)));
typedef short s16x4 __attribute__((ext_vector_type(4)));
typedef float f32x4 __attribute__((ext_vector_type(4)));
typedef float f32x16 __attribute__((ext_vector_type(16)));
typedef unsigned u32x4 __attribute__((ext_vector_type(4)));
typedef unsigned u32x2 __attribute__((ext_vector_type(2)));
typedef GAS unsigned gu32;
#define RLX_AGENT __ATOMIC_RELAXED, __HIP_MEMORY_SCOPE_AGENT
using pg8::cvt_pk_bf16; using pg8::pack8; using pg8::unpack8; using pg8::bf2f; using pg8::sigmoidf_; using pg8::siluf_;
using pg8::O_Y; using pg8::O_RETP; using pg8::O_RETS; using pg8::O_KVP; using pg8::O_KVS; using pg8::O_WINP; using pg8::O_WINS; using pg8::O_SREP; using pg8::O_SIMP; using pg8::O_SRES; using pg8::O_SIMS; using pg8::O_END;

constexpr int TP = 16384, TS = 1024, TT = 17408;
__device__ __forceinline__ void sincos_d(double x, float& s, float& c) {
    const double TWO_PI = 6.283185307179586476925, PI = 3.14159265358979323846;
    double r = x - rint(x / TWO_PI) * TWO_PI; double sg = 1.0;
    if (r > 0.5 * PI) { r = PI - r; sg = -1.0; } else if (r < -0.5 * PI) { r = -PI - r; sg = -1.0; }
    const double r2 = r * r;
    const double sp = r * (1.0 + r2 * (-1.0 / 6 + r2 * (1.0 / 120 + r2 * (-1.0 / 5040 + r2 * (1.0 / 362880 + r2 * (-1.0 / 39916800 + r2 * (1.0 / 6227020800.0)))))));
    const double cp = 1.0 + r2 * (-0.5 + r2 * (1.0 / 24 + r2 * (-1.0 / 720 + r2 * (1.0 / 40320 + r2 * (-1.0 / 3628800 + r2 * (1.0 / 479001600.0 + r2 * (-1.0 / 87178291200.0)))))));
    s = (float)sp; c = (float)(sg * cp);
}

namespace at {
typedef LAS const char* lcp;
typedef short v4i16_t __attribute__((ext_vector_type(4)));
__device__ __forceinline__ int crow(int r, int hi) { return (r & 3) + 8 * (r >> 2) + 4 * hi; }
__device__ __forceinline__ f32x16 mfma32(bf16x8 a, bf16x8 b, f32x16 c) { return __builtin_amdgcn_mfma_f32_32x32x16_bf16(a, b, c, 0, 0, 0); }
__device__ __forceinline__ s16x4 vtr(lcp p) { return __builtin_bit_cast(s16x4, __builtin_amdgcn_ds_read_tr16_b64_v4i16((LAS v4i16_t*)p)); }
__device__ __forceinline__ void qkt(f32x16& p0, f32x16& p1, lcp Kslot, const bf16x8* qr, int r32, int hi) {
    lcp kb = Kslot + hi * 1024 + r32 * 16;
    f32x16 z;
#pragma unroll
    for (int r = 0; r < 16; ++r) z[r] = 0.f;
    p0 = z; p1 = z;
#pragma unroll
    for (int d0 = 0; d0 < 4; ++d0) {
        const bf16x8 b0 = *(LAS const bf16x8*)(kb + d0 * 2048), b1 = *(LAS const bf16x8*)(kb + d0 * 2048 + 512);
        p0 = mfma32(b0, qr[d0], p0); p1 = mfma32(b1, qr[d0], p1); }
}
__device__ __forceinline__ int vlane_off(int lane) { const int hi = lane >> 5; return ((lane >> 4) & 1) * 32 + (lane & 3) * 8 + (4 * hi + ((lane & 15) >> 2)) * 64; }
__device__ __forceinline__ void pv(f32x16* o, lcp vp, const bf16x8* pa) {
#pragma unroll
    for (int d0 = 0; d0 < 2; ++d0)
#pragma unroll
        for (int ks = 0; ks < 4; ++ks) {
            const s16x4 lo = vtr(vp + d0 * 4096 + ks * 1024), hh = vtr(vp + d0 * 4096 + ks * 1024 + 512);
            const bf16x8 vf = {lo[0], lo[1], lo[2], lo[3], hh[0], hh[1], hh[2], hh[3]};
            o[d0] = mfma32(pa[ks], vf, o[d0]); }
}
__device__ __forceinline__ bf16x8 pk8(const f32x16& p, int b) { u32x4 w; w.x = cvt_pk_bf16(p[b], p[b + 1]); w.y = cvt_pk_bf16(p[b + 2], p[b + 3]); w.z = cvt_pk_bf16(p[b + 4], p[b + 5]); w.w = cvt_pk_bf16(p[b + 6], p[b + 7]); return __builtin_bit_cast(bf16x8, w); }
__device__ __forceinline__ void pack_p(bf16x8* pa, const f32x16& p0, const f32x16& p1) { pa[0] = pk8(p0, 0); pa[1] = pk8(p0, 8); pa[2] = pk8(p1, 0); pa[3] = pk8(p1, 8); }
__device__ __forceinline__ float rowmax32(const f32x16& p0, const f32x16& p1) {
    float m = fmaxf(p0[0], p1[0]);
#pragma unroll
    for (int r = 1; r < 16; ++r) m = fmaxf(m, fmaxf(p0[r], p1[r]));
    return fmaxf(m, __shfl_xor(m, 32));
}
__device__ __forceinline__ void mask_tile(f32x16& p0, f32x16& p1, int lo_excl, int hi_incl, int hi) {
    const unsigned span = (unsigned)(hi_incl - lo_excl); const int base = 4 * hi - lo_excl - 1;
#pragma unroll
    for (int r = 0; r < 16; ++r) { const int cr = (r & 3) + 8 * (r >> 2);
        p0[r] = ((unsigned)(cr + base) < span) ? p0[r] : -INFINITY;
        p1[r] = ((unsigned)(cr + 32 + base) < span) ? p1[r] : -INFINITY; }
}
struct St { f32x16 o[2]; float m, l; };
__device__ __forceinline__ void st_init(St& s) {
#pragma unroll
    for (int r = 0; r < 16; ++r) { s.o[0][r] = 0.f; s.o[1][r] = 0.f; }
    s.m = -INFINITY; s.l = 0.f; }
__device__ __forceinline__ void st_update(St& st, f32x16& p0, f32x16& p1, lcp vp, LAS float* wsf, int r32, int hi) {
    const float rm = rowmax32(p0, p1);
    const float mn = fmaxf(st.m, rm);
    const float mu = (mn == -INFINITY) ? 0.f : mn;
    const float alpha = __builtin_amdgcn_exp2f(st.m - mu);
    float s = 0.f;
#pragma unroll
    for (int r = 0; r < 16; ++r) { p0[r] = __builtin_amdgcn_exp2f(p0[r] - mu); p1[r] = __builtin_amdgcn_exp2f(p1[r] - mu); s += p0[r] + p1[r]; }
    s += __shfl_xor(s, 32);
    st.l = st.l * alpha + s; st.m = mn;
    if (__builtin_amdgcn_ballot_w64(alpha != 1.f) != 0ull) {
        if (hi == 0) wsf[r32] = alpha;
#pragma unroll
        for (int r = 0; r < 16; ++r) { const float a = wsf[crow(r, hi)]; st.o[0][r] *= a; st.o[1][r] *= a; } }
    bf16x8 pa[4]; pack_p(pa, p0, p1);
    pv(st.o, vp, pa);
}
__device__ __forceinline__ void glds16(const void* gsrc, unsigned lds_dst) { unsigned keep;
    asm volatile("s_mov_b32 %0, m0\n\ts_mov_b32 m0, %2\n\ts_nop 0\n\tglobal_load_lds_dwordx4 %1, off\n\ts_mov_b32 m0, %0" : "=&s"(keep) : "v"(gsrc), "s"(lds_dst) : "memory"); }
#define AT_WAIT_BAR(N) asm volatile("s_waitcnt vmcnt(" #N ") lgkmcnt(0)\n\ts_barrier" ::: "memory")
__device__ __forceinline__ void acc_scaled(f32x16* fin, const f32x16* o, float w, LAS float* wsf, int r32, int hi) {
    if (hi == 0) wsf[r32] = w;
#pragma unroll
    for (int r = 0; r < 16; ++r) { const float a = wsf[crow(r, hi)]; fin[0][r] += a * o[0][r]; fin[1][r] += a * o[1][r]; }
}
__device__ __forceinline__ void acc_stage(LAS float* stg, const f32x16* o, float w, LAS float* wsf, int r32, int hi, bool first) {
    if (hi == 0) wsf[r32] = w;
#pragma unroll
    for (int r = 0; r < 16; ++r) { const int orow = crow(r, hi); const float a = wsf[orow];
        const float v0 = a * o[0][r], v1 = a * o[1][r];
        if (first) { stg[orow * 64 + r32] = v0; stg[orow * 64 + 32 + r32] = v1; } else { stg[orow * 64 + r32] += v0; stg[orow * 64 + 32 + r32] += v1; } }
}
__device__ __forceinline__ u32x4 ldk_reg(const bf16* src, int pitch, int wid, int lane) { return *(const u32x4*)(src + (size_t)lane * pitch + wid * 8); }
__device__ __forceinline__ u32x4 ldv_reg(const bf16* src, int pitch, int wid, int lane) { return *(const u32x4*)(src + (size_t)(16 * (wid & 3) + (lane >> 2)) * pitch + (wid >> 2) * 32 + (lane & 3) * 8); }
__device__ __forceinline__ void st_slot(LAS char* slot, u32x4 v, int wid, int lane) { *(LAS u32x4*)(slot + wid * 1024 + lane * 16) = v; }
__device__ __forceinline__ void wave_tile_f32(const float* ksrc, const float* vsrc, size_t rs, LAS char* kslot, LAS char* vslot, int lane) {
    const int q = lane & 15, rr = lane >> 4;
#pragma unroll 1
    for (int i0 = 0; i0 < 16; i0 += 4) {
        f32x4 kv[4], vv[4];
#pragma unroll
        for (int i = 0; i < 4; ++i) { const size_t ro = (size_t)(4 * (i0 + i) + rr) * rs + 4 * q; kv[i] = __builtin_nontemporal_load((const f32x4*)(ksrc + ro)); vv[i] = __builtin_nontemporal_load((const f32x4*)(vsrc + ro)); }
#pragma unroll
        for (int i = 0; i < 4; ++i) { const int row = 4 * (i0 + i) + rr;
            u32x2 a, b; a.x = cvt_pk_bf16(kv[i][0], kv[i][1]); a.y = cvt_pk_bf16(kv[i][2], kv[i][3]); b.x = cvt_pk_bf16(vv[i][0], vv[i][1]); b.y = cvt_pk_bf16(vv[i][2], vv[i][3]);
            *(LAS u32x2*)(kslot + (q >> 1) * 1024 + row * 16 + (q & 1) * 8) = a;
            *(LAS u32x2*)(vslot + (q >> 3) * 4096 + row * 64 + (q & 7) * 8) = b; }
    }
}
__device__ __forceinline__ void wave_tile_new8(const bf16* ksrc, const bf16* vsrc, LAS char* kslot, LAS char* vslot, int lane) {
#pragma unroll
    for (int i = 0; i < 8; ++i) { const int pid = lane + 64 * i, row = pid >> 3, ch = pid & 7;
        u32x4 k = {0u, 0u, 0u, 0u}, v = {0u, 0u, 0u, 0u};
        if (row < 8) { k = *(const u32x4*)(ksrc + row * 64 + ch * 8); v = *(const u32x4*)(vsrc + row * 64 + ch * 8); }
        *(LAS u32x4*)(kslot + ch * 1024 + row * 16) = k;
        *(LAS u32x4*)(vslot + (ch >> 2) * 4096 + row * 64 + (ch & 3) * 16) = v; }
}
}
constexpr int NWAVES = 8;
constexpr int LDS_BYTES = 163840;
constexpr int MISC_OFF = LDS_BYTES - 512;
constexpr size_t MiB = 1u << 20;
constexpr size_t WS_CTL = 0, CTL_ZERO_BYTES = 1 * MiB;
constexpr size_t WS_W0T = 1 * MiB, WS_WO0T = 9 * MiB, WS_W1T = 11 * MiB, WS_WGT = 15 * MiB, WS_WO1T = 19 * MiB;
constexpr size_t WS_WCT = 21 * MiB, WS_CCONST = 21 * MiB + 768 * 1024, WS_ROPEC = 22 * MiB, WS_ROPES = 22 * MiB + 512 * 1024;
constexpr size_t WS_MT = 24 * MiB, WS_BST = 32 * MiB, WS_CXT = 36 * MiB, WS_L16 = 40 * MiB, WS_L8I = 40 * MiB + 256 * 1024;
constexpr size_t WS_H0 = 48 * MiB, WS_QA = 84 * MiB, WS_KA = 94 * MiB, WS_VA = 104 * MiB, WS_ZA = 122 * MiB, WS_QN = 140 * MiB, WS_ZB = 158 * MiB, WS_GATES = 176 * MiB;
constexpr size_t WS_KXP = 180 * MiB, WS_KXS = 206 * MiB, WS_CKP = 208 * MiB, WS_CKS = 209 * MiB, WS_RETA = 218 * MiB, WS_MIX = 236 * MiB, WS_Y0B = 272 * MiB;
constexpr size_t WS_U = 308 * MiB, WS_Z1 = 344 * MiB, WS_YG = 380 * MiB, WS_V1 = 416 * MiB, WS_END = 452 * MiB;
constexpr int CW_TMO = 0, CW_WQ = 64  , CW_BAR = 4096, CW_SS = 16384  ;
static_assert((CW_SS + TT) * 4 <= (int)CTL_ZERO_BYTES, "ctl");

struct Frame {
    LAS unsigned char* lds; volatile LAS unsigned* MISC; gu32* ctl;
    int tid, lane, wave, G;
    const float* in[29]; const int* ptab; float* out; unsigned char* ws;
};
#define WSP(T, off) ((T*)(F.ws + (off)))
#define UNIT_IDS() int tid = F.tid; asm volatile("" : "+v"(tid)); const int lane = tid & 63; const int wid = __builtin_amdgcn_readfirstlane(tid >> 6); (void)lane; (void)wid

__device__ __forceinline__ float wave_sum(float v) {
#pragma unroll
    for (int o = 1; o < 64; o <<= 1) v += __shfl_xor(v, o);
    return v;
}
__device__ __forceinline__ int wq_next(Frame& F, int q) {
    __syncthreads();
    if (F.tid == 0) F.MISC[16] = __hip_atomic_fetch_add(F.ctl + CW_WQ + 64 * q, 1u, RLX_AGENT);
    __syncthreads();
    return (int)F.MISC[16];
}

__device__ __forceinline__ void nsa_imp(const f32x16& a0, const f32x16& a1, const f32x16& b0, const f32x16& b1, LAS float* imp, int lane) {
    const int r32 = lane & 31, hi = lane >> 5;
    float eprev = 0.f;
#pragma unroll
    for (int i = 0; i < 16; ++i) {
        const f32x16& X = (i < 4) ? a0 : (i < 8) ? a1 : (i < 12) ? b0 : b1; const int q4 = i & 3;
        const float G = (X[4 * q4] + X[4 * q4 + 1]) + (X[4 * q4 + 2] + X[4 * q4 + 3]), E = X[4 * q4 + 3];
        const float eo = __shfl_xor(E, 32);
        float v = G + (hi ? eo : eprev); eprev = eo;
        v += __shfl_xor(v, 1); v += __shfl_xor(v, 2);
        if ((r32 & 3) == 0) imp[(r32 >> 2) * 33 + 2 * i + hi] = v; }
}
__device__ __forceinline__ unsigned nsa_rank(LAS float* imp, int cur, bool samp, int lane) {
    const int r32 = lane & 31;
    const int q = lane >> 3, j = lane & 7;
    float sc[4]; int rk[4];
#pragma unroll
    for (int k = 0; k < 4; ++k) { const int s = 4 * j + k; const bool valid = s <= cur, forced = (s == 0) || (s == cur) || (s == cur - 1);
        sc[k] = valid ? (forced ? 1e4f : imp[q * 33 + s]) : -1e4f; rk[k] = (samp && !forced) ? 1 : 0; }
#pragma unroll 4
    for (int s2 = 0; s2 < 32; ++s2) {
        const bool valid = s2 <= cur, forced = (s2 == 0) || (s2 == cur) || (s2 == cur - 1);
        const float v2 = valid ? (forced ? 1e4f : imp[q * 33 + s2]) : -1e4f;
#pragma unroll
        for (int k = 0; k < 4; ++k) rk[k] += (v2 > sc[k] || (v2 == sc[k] && s2 < 4 * j + k)) ? 1 : 0; }
    unsigned mask = 0u;
#pragma unroll
    for (int k = 0; k < 4; ++k) if (4 * j + k <= cur && rk[k] < 8) mask |= 1u << (4 * j + k);
    mask |= __shfl_xor(mask, 1); mask |= __shfl_xor(mask, 2); mask |= __shfl_xor(mask, 4);
    return (unsigned)__shfl((int)mask, 8 * (r32 >> 2));
}

__device__ __forceinline__ void nsa_cmp(f32x16* oc, LAS float* imp, at::lcp k0, at::lcp k1, at::lcp v0, at::lcp v1, bool two, int nmax, const bf16x8* qr, int lane) {
    const int r32 = lane & 31, hi = lane >> 5;
    f32x16 a0, a1, b0, b1;
    at::qkt(a0, a1, k0, qr, r32, hi);
    if (two) at::qkt(b0, b1, k1, qr, r32, hi);
    at::mask_tile(a0, a1, -1, nmax < 0 ? -1 : (nmax > 63 ? 63 : nmax), hi);
    if (two) at::mask_tile(b0, b1, -1, nmax < 64 ? -1 : (nmax > 127 ? 63 : nmax - 64), hi);
    else {
#pragma unroll
        for (int r = 0; r < 16; ++r) { b0[r] = -INFINITY; b1[r] = -INFINITY; } }
    float rm = fmaxf(at::rowmax32(a0, a1), at::rowmax32(b0, b1));
    const float mu = (rm == -INFINITY) ? 0.f : rm;
    float s = 0.f;
#pragma unroll
    for (int r = 0; r < 16; ++r) { a0[r] = __builtin_amdgcn_exp2f(a0[r] - mu); a1[r] = __builtin_amdgcn_exp2f(a1[r] - mu); b0[r] = __builtin_amdgcn_exp2f(b0[r] - mu); b1[r] = __builtin_amdgcn_exp2f(b1[r] - mu);
        s += (a0[r] + a1[r]) + (b0[r] + b1[r]); }
    s += __shfl_xor(s, 32);
    const float inv = s > 0.f ? 1.f / s : 0.f;
#pragma unroll
    for (int r = 0; r < 16; ++r) { a0[r] *= inv; a1[r] *= inv; b0[r] *= inv; b1[r] *= inv; }
    nsa_imp(a0, a1, b0, b1, imp, lane);
    bf16x8 pa[4], pb[4]; at::pack_p(pa, a0, a1); at::pack_p(pb, b0, b1);
    asm volatile("" : "+v"(pa[0]), "+v"(pa[1]), "+v"(pa[2]), "+v"(pa[3]), "+v"(pb[0]), "+v"(pb[1]), "+v"(pb[2]), "+v"(pb[3]));
#pragma unroll
    for (int r = 0; r < 16; ++r) { oc[0][r] = 0.f; oc[1][r] = 0.f; }
    at::pv(oc, v0, pa);
    if (two) at::pv(oc, v1, pb);
}

__device__ __forceinline__ void nsa_prompt_unit(Frame& F, int b, int g, int c) {
    UNIT_IDS(); const int r32 = lane & 31, hi = lane >> 5;
    LAS char* L = (LAS char*)F.lds;
    LAS char* KS0 = L; LAS char* KS1 = L + 16384; LAS char* VS0 = L + 8192; LAS char* VS1 = L + 24576;
    LAS float* stg = (LAS float*)(L + 81920 + 8192 * wid); LAS float* wsf = (LAS float*)(L + 147456 + 512 * wid); LAS float* imp = (LAS float*)(L + 151552 + 1152 * wid);
    const int voff = at::vlane_off(lane);
    const int ql = 8 * wid + (r32 >> 2), h = r32 & 3, tpos = 64 * c + ql, head = 4 * g + h;
    const size_t token = (size_t)b * 2048 + tpos;
    const bf16* QN = WSP(const bf16, WS_QN); const float* GT = WSP(const float, WS_GATES);
    bf16x8 qr[4];
#pragma unroll
    for (int d0 = 0; d0 < 4; ++d0) qr[d0] = *(const bf16x8*)(QN + token * 512 + head * 64 + d0 * 16 + hi * 8);
    const float g0 = GT[token * 24 + head * 3 + 0], g1 = GT[token * 24 + head * 3 + 1], g2 = GT[token * 24 + head * 3 + 2];
    unsigned selm;
#ifndef X_NO_CMP
    {
        const bf16* CK = WSP(const bf16, WS_CKP) + ((size_t)(0 * 8 + b) * 2 + g) * 8192; const bf16* CV = WSP(const bf16, WS_CKP) + ((size_t)(1 * 8 + b) * 2 + g) * 8192;
        const bool two = c >= 16;
        at::st_slot(KS0, at::ldk_reg(CK, 64, wid, lane), wid, lane); at::st_slot(VS0, at::ldv_reg(CV, 64, wid, lane), wid, lane);
        if (two) { at::st_slot(KS1, at::ldk_reg(CK + 4096, 64, wid, lane), wid, lane); at::st_slot(VS1, at::ldv_reg(CV + 4096, 64, wid, lane), wid, lane); }
        __syncthreads();
        f32x16 oc[2];
        const int nmax = (tpos - 31) >> 4;
        nsa_cmp(oc, imp, KS0, KS1, VS0 + voff, VS1 + voff, two, nmax, qr, lane);
        selm = nsa_rank(imp, c, false, lane);
        at::acc_stage(stg, oc, g0, wsf, r32, hi, true);
        __syncthreads();
    }
#else
    selm = 0xffffffffu;
#endif
    __builtin_amdgcn_sched_barrier(0);
#ifndef X_NO_LOOP
    const unsigned lds0 = (unsigned)(size_t)L;
    const unsigned kdst = (unsigned)__builtin_amdgcn_readfirstlane((int)(lds0 + wid * 1024)), vdst = kdst + 8192;
    const int koff = lane * 64 + wid * 8, voffg = (16 * (wid & 3) + (lane >> 2)) * 64 + (wid >> 2) * 32 + (lane & 3) * 8;
    asm volatile("s_waitcnt vmcnt(0)" ::: "memory");
#pragma unroll 1
    for (int br = 0; br < 2; ++br) {
        const bf16* Kb = WSP(const bf16, WS_KXP) + ((size_t)((br ? 4 : 2) * 8 + b) * 2 + g) * 131072;
        const bf16* Vb = WSP(const bf16, WS_KXP) + ((size_t)((br ? 5 : 3) * 8 + b) * 2 + g) * 131072;
        const int t0 = br ? (c > 8 ? c - 8 : 0) : 0, nt = c - t0 + 1;
        at::St st; at::st_init(st);
#define NSA_DMA(j, slot) do { at::glds16(Kb + (size_t)(t0 + (j)) * 4096 + koff, kdst + (unsigned)(slot) * 16384u); at::glds16(Vb + (size_t)(t0 + (j)) * 4096 + voffg, vdst + (unsigned)(slot) * 16384u); } while (0)
        NSA_DMA(0, 0); if (nt > 1) NSA_DMA(1, 1); if (nt > 2) NSA_DMA(2, 2);
        int sl_cur = 0, sl_new = 3;
#pragma unroll 1
        for (int i = 0; i < nt; ++i) {
            const int t = t0 + i, ahead = nt - 1 - i;
            if (ahead >= 3) { NSA_DMA(i + 3, sl_new); sl_new = sl_new == 4 ? 0 : sl_new + 1; }
            if (ahead >= 3) AT_WAIT_BAR(6); else if (ahead == 2) AT_WAIT_BAR(4); else if (ahead == 1) AT_WAIT_BAR(2); else AT_WAIT_BAR(0);
            LAS char* Kc = L + sl_cur * 16384; LAS char* Vc = Kc + 8192; sl_cur = sl_cur == 4 ? 0 : sl_cur + 1;
            f32x16 p0, p1; at::qkt(p0, p1, Kc, qr, r32, hi);
            int lo_excl, hi_incl;
            if (br == 0) { lo_excl = -1; hi_incl = (t == c) ? ql : 63; if (!((selm >> t) & 1u)) hi_incl = -1; }
            else { lo_excl = (t == c - 8) ? ql : -1; hi_incl = (t == c) ? ql : 63; }
            at::mask_tile(p0, p1, lo_excl, hi_incl, hi);
            at::st_update(st, p0, p1, Vc + voff, wsf, r32, hi);
        }
#undef NSA_DMA
        at::acc_stage(stg, st.o, (br ? g2 : g1) / st.l, wsf, r32, hi, false);
        AT_WAIT_BAR(0);
    }
#endif
    __builtin_amdgcn_sched_barrier(0);
    const bf16* ZB = WSP(const bf16, WS_ZB); bf16* MIX = WSP(bf16, WS_MIX);
#pragma unroll
    for (int i = 0; i < 4; ++i) { const int row = i * 8 + (lane >> 3), ch = lane & 7;
        const size_t tok = (size_t)b * 2048 + 64 * c + 8 * wid + (row >> 2); const int hd = 4 * g + (row & 3);
        float z[8], v[8]; unpack8(*(const u32x4*)(ZB + tok * 512 + hd * 64 + ch * 8), z);
        const f32x4 x0 = *(LAS const f32x4*)(stg + row * 64 + ch * 8), x1 = *(LAS const f32x4*)(stg + row * 64 + ch * 8 + 4);
#pragma unroll
        for (int j = 0; j < 4; ++j) { v[j] = x0[j] * siluf_(z[j]); v[4 + j] = x1[j] * siluf_(z[4 + j]); }
        *(u32x4*)(MIX + tok * 1024 + 512 + hd * 64 + ch * 8) = pack8(v); }
}

__device__ __forceinline__ void nsa_sample_unit(Frame& F, int b, int g) {
    UNIT_IDS(); const int r32 = lane & 31, hi = lane >> 5;
    LAS char* L = (LAS char*)F.lds;
    LAS char* KP = L + 16384 * wid; LAS char* VP = KP + 8192;
    LAS float* wsf = (LAS float*)(L + 131072 + 512 * wid); LAS float* imp = (LAS float*)(L + 135168 + 1152 * wid);
    LAS float* MM = (LAS float*)(L + 144384); LAS float* LL = (LAS float*)(L + 146432); LAS float* OC = (LAS float*)(L + 148480); LAS float* GW = (LAS float*)(L + 156672);
    const int voff = at::vlane_off(lane);
    const int ql = r32 >> 2, h = r32 & 3, head = 4 * g + h;
    const size_t token = (size_t)TP + b * 8 + ql;
    const bf16* QN = WSP(const bf16, WS_QN); const float* GT = WSP(const float, WS_GATES);
    bf16x8 qr[4];
#pragma unroll
    for (int d0 = 0; d0 < 4; ++d0) qr[d0] = *(const bf16x8*)(QN + token * 512 + head * 64 + d0 * 16 + hi * 8);
    unsigned selm;
    {
        const bf16* CK = WSP(const bf16, WS_CKS) + ((size_t)(0 * 128 + b) * 2 + g) * 8192; const bf16* CV = WSP(const bf16, WS_CKS) + ((size_t)(1 * 128 + b) * 2 + g) * 8192;
        at::st_slot(L, at::ldk_reg(CK, 64, wid, lane), wid, lane); at::st_slot(L + 8192, at::ldv_reg(CV, 64, wid, lane), wid, lane);
        at::st_slot(L + 16384, at::ldk_reg(CK + 4096, 64, wid, lane), wid, lane); at::st_slot(L + 24576, at::ldv_reg(CV + 4096, 64, wid, lane), wid, lane);
        __syncthreads();
        f32x16 oc[2];
        nsa_cmp(oc, imp, L, L + 16384, L + 8192 + voff, L + 24576 + voff, true, 126, qr, lane);
        selm = nsa_rank(imp, 32, true, lane);
        if (wid == 0) {
#pragma unroll
            for (int r = 0; r < 16; ++r) { const int orow = at::crow(r, hi); OC[orow * 64 + r32] = oc[0][r]; OC[orow * 64 + 32 + r32] = oc[1][r]; }
            if (hi == 0) { GW[r32] = GT[token * 24 + head * 3 + 0]; GW[32 + r32] = GT[token * 24 + head * 3 + 1]; GW[64 + r32] = GT[token * 24 + head * 3 + 2]; } }
        __syncthreads();
    }
    unsigned un = selm;
#pragma unroll
    for (int o = 4; o < 32; o <<= 1) un |= __shfl_xor(un, o);
    un = (unsigned)__builtin_amdgcn_readfirstlane(un);
    at::St ss, sw; at::st_init(ss);
    const float* cache = F.in[2]; const float* cwin = F.in[3];
    const bf16* KXS = WSP(const bf16, WS_KXS);
    int idx = 0;
#pragma unroll 1
    for (int s = 0; s <= 32; ++s) {
        if (s < 32 && !((un >> s) & 1u)) continue;
        if (((idx++) & 7) != wid) continue;
        if (s < 32) { const int page = F.ptab[b * 16 + (s >> 1)];
            const float* base = cache + ((size_t)page * 128 + (s & 1) * 64) * 512 + g * 64;
            at::wave_tile_f32(base + 2 * 128, base + 3 * 128, 512, KP, VP, lane); }
        else at::wave_tile_new8(KXS + (size_t)2 * 131072 + (size_t)b * 1024 + g * 512, KXS + (size_t)3 * 131072 + (size_t)b * 1024 + g * 512, KP, VP, lane);
        f32x16 p0, p1; at::qkt(p0, p1, KP, qr, r32, hi);
        int hi_incl = s < 32 ? 63 : ql; if (s < 32 && !((selm >> s) & 1u)) hi_incl = -1;
        at::mask_tile(p0, p1, -1, hi_incl, hi);
        at::st_update(ss, p0, p1, VP + voff, wsf, r32, hi);
    }
    __builtin_amdgcn_sched_barrier(0);
    at::st_init(sw);
#pragma unroll 1
    for (int j = 0; j <= 8; ++j) {
        if (((idx++) & 7) != wid) continue;
        if (j < 8) { const float* base = cwin + ((size_t)b * 512 + 64 * j) * 256 + g * 64; at::wave_tile_f32(base, base + 128, 256, KP, VP, lane); }
        else at::wave_tile_new8(KXS + (size_t)4 * 131072 + (size_t)b * 1024 + g * 512, KXS + (size_t)5 * 131072 + (size_t)b * 1024 + g * 512, KP, VP, lane);
        f32x16 p0, p1; at::qkt(p0, p1, KP, qr, r32, hi);
        at::mask_tile(p0, p1, j == 0 ? ql : -1, j == 8 ? ql : 63, hi);
        at::st_update(sw, p0, p1, VP + voff, wsf, r32, hi);
    }
    if (hi == 0) { MM[(0 * 8 + wid) * 32 + r32] = ss.m; MM[(1 * 8 + wid) * 32 + r32] = sw.m; }
    __syncthreads();
    {
        float Ms = -INFINITY, Mw = -INFINITY;
#pragma unroll
        for (int w = 0; w < 8; ++w) { Ms = fmaxf(Ms, MM[(0 * 8 + w) * 32 + r32]); Mw = fmaxf(Mw, MM[(1 * 8 + w) * 32 + r32]); }
        const float fs = __builtin_amdgcn_exp2f(ss.m - Ms), fw = __builtin_amdgcn_exp2f(sw.m - Mw);
        if (hi == 0) { LL[(0 * 8 + wid) * 32 + r32] = ss.l * fs; LL[(1 * 8 + wid) * 32 + r32] = sw.l * fw; }
        LAS float* OPs = (LAS float*)(L + (0 * 8 + wid) * 8192); LAS float* OPw = (LAS float*)(L + (1 * 8 + wid) * 8192);
        if (hi == 0) wsf[r32] = fs;
#pragma unroll
        for (int r = 0; r < 16; ++r) { const int orow = at::crow(r, hi); const float a = wsf[orow]; OPs[orow * 64 + r32] = ss.o[0][r] * a; OPs[orow * 64 + 32 + r32] = ss.o[1][r] * a; }
        if (hi == 0) wsf[32 + r32] = fw;
#pragma unroll
        for (int r = 0; r < 16; ++r) { const int orow = at::crow(r, hi); const float a = wsf[32 + orow]; OPw[orow * 64 + r32] = sw.o[0][r] * a; OPw[orow * 64 + 32 + r32] = sw.o[1][r] * a; }
    }
    __syncthreads();
    {
        const int row = tid >> 4, dq = (tid & 15) * 4;
        f32x4 os = {0.f, 0.f, 0.f, 0.f}, ow = {0.f, 0.f, 0.f, 0.f}; float ls = 0.f, lw = 0.f;
#pragma unroll
        for (int w = 0; w < 8; ++w) { os = os + *(LAS const f32x4*)(L + (0 * 8 + w) * 8192 + (row * 64 + dq) * 4); ow = ow + *(LAS const f32x4*)(L + (1 * 8 + w) * 8192 + (row * 64 + dq) * 4);
            ls += LL[(0 * 8 + w) * 32 + row]; lw += LL[(1 * 8 + w) * 32 + row]; }
        const f32x4 oc = *(LAS const f32x4*)(OC + row * 64 + dq);
        const float w0 = GW[row], w1 = GW[32 + row] / ls, w2 = GW[64 + row] / lw;
        const size_t tok = (size_t)TP + b * 8 + (row >> 2); const int hd = 4 * g + (row & 3);
        const bf16* ZB = WSP(const bf16, WS_ZB); bf16* MIX = WSP(bf16, WS_MIX);
        const u32x2 zr = *(const u32x2*)(ZB + tok * 512 + hd * 64 + dq);
        const float z0 = __uint_as_float(zr.x << 16), z1 = __uint_as_float(zr.x & 0xffff0000u), z2 = __uint_as_float(zr.y << 16), z3 = __uint_as_float(zr.y & 0xffff0000u);
        const float v0 = (w0 * oc[0] + w1 * os[0] + w2 * ow[0]) * siluf_(z0), v1 = (w0 * oc[1] + w1 * os[1] + w2 * ow[1]) * siluf_(z1);
        const float v2 = (w0 * oc[2] + w1 * os[2] + w2 * ow[2]) * siluf_(z2), v3 = (w0 * oc[3] + w1 * os[3] + w2 * ow[3]) * siluf_(z3);
        u32x2 o; o.x = cvt_pk_bf16(v0, v1); o.y = cvt_pk_bf16(v2, v3);
        *(u32x2*)(MIX + tok * 1024 + 512 + hd * 64 + dq) = o;
    }
}
__device__ __forceinline__ float ret_log2g(int h) { return log2f(1.f - exp2f(-5.f - (float)h)); }
__device__ __forceinline__ void ret_r1_unit(Frame& F, int b, int h, int c) {
    UNIT_IDS();
    LAS float* Kd = (LAS float*)F.lds; LAS float* Vl = (LAS float*)(F.lds + 32768);
    const bf16* KA = WSP(const bf16, WS_KA); const bf16* VA = WSP(const bf16, WS_VA);
    const size_t tok0 = (size_t)b * 2048 + 128 * c; const float l2g = ret_log2g(h);
    for (int p = tid; p < 128 * 8; p += 512) { const int j = p >> 3, ch = p & 7; float v[8]; unpack8(*(const u32x4*)(KA + (tok0 + j) * 256 + h * 64 + ch * 8), v);
        const float dec = exp2f((float)(127 - j) * l2g);
        *(LAS f32x4*)(Kd + j * 64 + ch * 8) = (f32x4){v[0] * dec, v[1] * dec, v[2] * dec, v[3] * dec}; *(LAS f32x4*)(Kd + j * 64 + ch * 8 + 4) = (f32x4){v[4] * dec, v[5] * dec, v[6] * dec, v[7] * dec}; }
    for (int p = tid; p < 128 * 16; p += 512) { const int j = p >> 4, ch = p & 15; float v[8]; unpack8(*(const u32x4*)(VA + (tok0 + j) * 512 + h * 128 + ch * 8), v);
        *(LAS f32x4*)(Vl + j * 128 + ch * 8) = (f32x4){v[0], v[1], v[2], v[3]}; *(LAS f32x4*)(Vl + j * 128 + ch * 8 + 4) = (f32x4){v[4], v[5], v[6], v[7]}; }
    __syncthreads();
    const int dvq = tid & 31, dkg = tid >> 5;
    f32x4 acc[4];
#pragma unroll
    for (int i = 0; i < 4; ++i) acc[i] = (f32x4){0.f, 0.f, 0.f, 0.f};
#pragma unroll 4
    for (int j = 0; j < 128; ++j) { const f32x4 kk = *(LAS const f32x4*)(Kd + j * 64 + dkg * 4), vv = *(LAS const f32x4*)(Vl + j * 128 + dvq * 4);
#pragma unroll
        for (int i = 0; i < 4; ++i) acc[i] += kk[i] * vv; }
    float* A = WSP(float, WS_RETA) + ((size_t)(b * 4 + h) * 16 + c) * 8192;
#pragma unroll
    for (int i = 0; i < 4; ++i) *(f32x4*)(A + (dkg * 4 + i) * 128 + dvq * 4) = acc[i];
}
__device__ __forceinline__ void ret_r2_unit(Frame& F, int b, int h, int c) {
    UNIT_IDS(); const int r32 = lane & 31, hi = lane >> 5;
    LAS char* L = (LAS char*)F.lds;
    LAS float* stats = (LAS float*)(L + 65536);
    const bf16* QA = WSP(const bf16, WS_QA); const bf16* KA = WSP(const bf16, WS_KA); const bf16* VA = WSP(const bf16, WS_VA);
    const size_t tok0 = (size_t)b * 2048 + 128 * c; const float l2g = ret_log2g(h);
#pragma unroll
    for (int t = 0; t < 2; ++t) {
        at::st_slot(L + 8192 * t, *(const u32x4*)(KA + (tok0 + 64 * t + lane) * 256 + h * 64 + wid * 8), wid, lane);
#pragma unroll
        for (int i = 0; i < 2; ++i) { const int pid = tid + 512 * i, row = pid >> 4, q = pid & 15;
            *(LAS u32x4*)(L + 16384 + 16384 * t + (q >> 2) * 4096 + row * 64 + (q & 3) * 16) = *(const u32x4*)(VA + (tok0 + 64 * t + row) * 512 + h * 128 + q * 8); }
    }
    {
        const float* A = WSP(const float, WS_RETA) + (size_t)(b * 4 + h) * 16 * 8192; const float cd = exp2f(128.f * l2g);
        f32x4 s[4];
#pragma unroll
        for (int i = 0; i < 4; ++i) s[i] = (f32x4){0.f, 0.f, 0.f, 0.f};
        for (int cc = 0; cc < c; ++cc) {
#pragma unroll
            for (int i = 0; i < 4; ++i) s[i] = s[i] * cd + *(const f32x4*)(A + (size_t)cc * 8192 + 4 * tid + 2048 * i); }
#pragma unroll
        for (int i = 0; i < 4; ++i) { const int e = 4 * tid + 2048 * i, dk = e >> 7, dv = e & 127;
            u32x2 w; w.x = cvt_pk_bf16(s[i][0], s[i][1]); w.y = cvt_pk_bf16(s[i][2], s[i][3]);
            *(LAS u32x2*)(L + 49152 + (dv >> 5) * 4096 + dk * 64 + (dv & 31) * 2) = w; }
        if (c == 15) {
#pragma unroll
            for (int i = 0; i < 4; ++i) { const f32x4 fin = s[i] * cd + *(const f32x4*)(A + (size_t)15 * 8192 + 4 * tid + 2048 * i);
                *(f32x4*)(F.out + O_RETP + (size_t)(b * 4 + h) * 8192 + 4 * tid + 2048 * i) = fin; } }
    }
    __syncthreads();
    const int wq = wid & 3, dvh = wid >> 2, i_row = 32 * wq + r32;
    const int voff = at::vlane_off(lane);
    f32x16 o[2];
#pragma unroll
    for (int r = 0; r < 16; ++r) { o[0][r] = 0.f; o[1][r] = 0.f; }
    const bf16* qrow = QA + (tok0 + i_row) * 256 + h * 64;
    {
        const float qd = exp2f((float)(i_row + 1) * l2g);
        bf16x8 pa[4];
#pragma unroll
        for (int ks = 0; ks < 4; ++ks) {
            const u32x2 lo2 = *(const u32x2*)(qrow + 16 * ks + 4 * hi), hi2 = *(const u32x2*)(qrow + 16 * ks + 8 + 4 * hi);
            u32x4 w; w.x = cvt_pk_bf16(__uint_as_float(lo2.x << 16) * qd, __uint_as_float(lo2.x & 0xffff0000u) * qd); w.y = cvt_pk_bf16(__uint_as_float(lo2.y << 16) * qd, __uint_as_float(lo2.y & 0xffff0000u) * qd);
            w.z = cvt_pk_bf16(__uint_as_float(hi2.x << 16) * qd, __uint_as_float(hi2.x & 0xffff0000u) * qd); w.w = cvt_pk_bf16(__uint_as_float(hi2.y << 16) * qd, __uint_as_float(hi2.y & 0xffff0000u) * qd);
            pa[ks] = __builtin_bit_cast(bf16x8, w); }
        at::pv(o, L + 49152 + dvh * 8192 + voff, pa);
    }
    bf16x8 qr[4];
#pragma unroll
    for (int d0 = 0; d0 < 4; ++d0) qr[d0] = *(const bf16x8*)(qrow + d0 * 16 + hi * 8);
#pragma unroll
    for (int t = 0; t < 2; ++t) {
        if (64 * t <= 32 * wq + 31) {
            f32x16 p0, p1; at::qkt(p0, p1, L + 8192 * t, qr, r32, hi);
#pragma unroll
            for (int r = 0; r < 16; ++r) { const int j0 = 64 * t + at::crow(r, hi), j1 = j0 + 32;
                p0[r] = (i_row >= j0) ? p0[r] * exp2f((float)(i_row - j0) * l2g) : 0.f;
                p1[r] = (i_row >= j1) ? p1[r] * exp2f((float)(i_row - j1) * l2g) : 0.f; }
            bf16x8 pa[4]; at::pack_p(pa, p0, p1);
            at::pv(o, L + 16384 + 16384 * t + dvh * 8192 + voff, pa);
        }
    }
    float sm[16], sq[16];
#pragma unroll
    for (int r = 0; r < 16; ++r) { sm[r] = o[0][r] + o[1][r]; sq[r] = o[0][r] * o[0][r] + o[1][r] * o[1][r]; }
#pragma unroll
    for (int r = 0; r < 16; ++r) {
#pragma unroll
        for (int off = 1; off < 32; off <<= 1) { sm[r] += __shfl_xor(sm[r], off); sq[r] += __shfl_xor(sq[r], off); }
        if (r32 == 0) { stats[(wid * 32 + at::crow(r, hi)) * 2] = sm[r]; stats[(wid * 32 + at::crow(r, hi)) * 2 + 1] = sq[r]; } }
    __syncthreads();
    const float* gn = F.in[11]; const bf16* ZA = WSP(const bf16, WS_ZA); bf16* MIX = WSP(bf16, WS_MIX);
#pragma unroll
    for (int r = 0; r < 16; ++r) { const int row = at::crow(r, hi); const int pw = wid ^ 4;
        const float s1 = sm[r] + stats[(pw * 32 + row) * 2], s2 = sq[r] + stats[(pw * 32 + row) * 2 + 1];
        const float mu = s1 * (1.f / 128.f), var = s2 * (1.f / 128.f) - mu * mu, rstd = 1.f / sqrtf(var + 1e-6f);
        const size_t tok = tok0 + 32 * wq + row;
#pragma unroll
        for (int d0 = 0; d0 < 2; ++d0) { const int ch = h * 128 + 64 * dvh + 32 * d0 + r32;
            const float y = (o[d0][r] - mu) * rstd * gn[ch] * siluf_(bf2f(ZA[tok * 512 + ch]));
            MIX[tok * 1024 + ch] = (bf16)(cvt_pk_bf16(y, 0.f) & 0xffffu); } }
}
__device__ __forceinline__ void ret_sample_unit(Frame& F, int b, int h) {
    UNIT_IDS(); LAS char* L = (LAS char*)F.lds;
    LAS float* part = (LAS float*)L; LAS float* ql = (LAS float*)(L + 65536); LAS float* kl = (LAS float*)(L + 67584); LAS float* vl = (LAS float*)(L + 69632); LAS float* ol = (LAS float*)(L + 73728);
    const bf16* QA = WSP(const bf16, WS_QA); const bf16* KA = WSP(const bf16, WS_KA); const bf16* VA = WSP(const bf16, WS_VA);
    const size_t tok0 = (size_t)TP + b * 8; const float l2g = ret_log2g(h);
    { const int i = tid >> 6, d = tid & 63; ql[i * 64 + d] = bf2f(QA[(tok0 + i) * 256 + h * 64 + d]); kl[i * 64 + d] = bf2f(KA[(tok0 + i) * 256 + h * 64 + d]); }
    for (int p = tid; p < 8 * 128; p += 512) { const int i = p >> 7, d = p & 127; vl[p] = bf2f(VA[(tok0 + i) * 512 + h * 128 + d]); }
    __syncthreads();
    const int dvq = tid & 31, dkg = tid >> 5;
    const float* S0 = F.in[4] + (size_t)(b * 4 + h) * 8192; float* S1 = F.out + O_RETS + (size_t)(b * 4 + h) * 8192;
    f32x4 s[4];
#pragma unroll
    for (int i = 0; i < 4; ++i) s[i] = __builtin_nontemporal_load((const f32x4*)(S0 + (dkg * 4 + i) * 128 + dvq * 4));
#pragma unroll
    for (int t = 0; t < 8; ++t) { const float qd = exp2f((float)(t + 1) * l2g); f32x4 a = {0.f, 0.f, 0.f, 0.f};
#pragma unroll
        for (int i = 0; i < 4; ++i) a += (ql[t * 64 + dkg * 4 + i] * qd) * s[i];
        *(LAS f32x4*)(part + (dkg * 8 + t) * 128 + dvq * 4) = a; }
    const float cd = exp2f(8.f * l2g);
#pragma unroll
    for (int i = 0; i < 4; ++i) { f32x4 n = s[i] * cd;
#pragma unroll
        for (int j = 0; j < 8; ++j) n += (kl[j * 64 + dkg * 4 + i] * exp2f((float)(7 - j) * l2g)) * *(LAS const f32x4*)(vl + j * 128 + dvq * 4);
        *(f32x4*)(S1 + (dkg * 4 + i) * 128 + dvq * 4) = n; }
    __syncthreads();
    {
        const int t = wid;
        float o0 = 0.f, o1 = 0.f;
#pragma unroll
        for (int gq = 0; gq < 16; ++gq) { o0 += part[(gq * 8 + t) * 128 + lane]; o1 += part[(gq * 8 + t) * 128 + 64 + lane]; }
        for (int j = 0; j <= t; ++j) { float d = 0.f;
#pragma unroll 8
            for (int k = 0; k < 64; ++k) d += ql[t * 64 + k] * kl[j * 64 + k];
            d *= exp2f((float)(t - j) * l2g); o0 += d * vl[j * 128 + lane]; o1 += d * vl[j * 128 + 64 + lane]; }
        const float mu = wave_sum(o0 + o1) * (1.f / 128.f); const float var = wave_sum(o0 * o0 + o1 * o1) * (1.f / 128.f) - mu * mu, rstd = 1.f / sqrtf(var + 1e-6f);
        const float* gn = F.in[11]; const bf16* ZA = WSP(const bf16, WS_ZA); bf16* MIX = WSP(bf16, WS_MIX); const size_t tok = tok0 + t;
        const int c0 = h * 128 + lane, c1 = c0 + 64;
        const float y0 = (o0 - mu) * rstd * gn[c0] * siluf_(bf2f(ZA[tok * 512 + c0])), y1 = (o1 - mu) * rstd * gn[c1] * siluf_(bf2f(ZA[tok * 512 + c1]));
        MIX[tok * 1024 + c0] = (bf16)(cvt_pk_bf16(y0, 0.f) & 0xffffu); MIX[tok * 1024 + c1] = (bf16)(cvt_pk_bf16(y1, 0.f) & 0xffffu);
        (void)ol;
    }
}

__device__ __forceinline__ void cmp_unit(Frame& F, int b, int c, bool samp) {
    UNIT_IDS(); const int r32 = lane & 31, hi = lane >> 5;
    LAS char* L = (LAS char*)F.lds;
    const int g = wid >> 2, m = 32 * (wid & 3) + r32;
    const bf16* WCT = WSP(const bf16, WS_WCT) + (size_t)c * 131072;
    const float* srcf = nullptr; const bf16* srcb = nullptr;
    if (samp) { const int page = F.ptab[b * 16 + (m >> 3)]; srcf = F.in[2] + ((size_t)page * 128 + 16 * (m & 7)) * 512 + c * 128 + g * 64 + 8 * hi; }
    else srcb = WSP(const bf16, WS_KXP) + ((size_t)(c * 8 + b) * 2 + g) * 131072 + (size_t)(16 * m) * 64 + 8 * hi;
    f32x16 acc[4];
#pragma unroll
    for (int j = 0; j < 4; ++j)
#pragma unroll
        for (int r = 0; r < 16; ++r) acc[j][r] = 0.f;
#pragma unroll 1
    for (int kc = 0; kc < 2; ++kc) {
        __syncthreads();
#pragma unroll
        for (int i = 0; i < 16; ++i) { const int pid = tid + 512 * i, n = pid >> 6, q = pid & 63;
            *(LAS u32x4*)(L + n * 1040 + q * 16) = *(const u32x4*)(WCT + (size_t)n * 1024 + 512 * kc + q * 8); }
        __syncthreads();
#pragma unroll 4
        for (int ks = 0; ks < 32; ++ks) {
            const int kg = 512 * kc + 16 * ks, l = kg >> 6, d0 = kg & 63;
            bf16x8 a;
            if (samp) { const f32x4 x0 = __builtin_nontemporal_load((const f32x4*)(srcf + (size_t)l * 512 + d0)), x1 = __builtin_nontemporal_load((const f32x4*)(srcf + (size_t)l * 512 + d0 + 4));
                u32x4 w; w.x = cvt_pk_bf16(x0[0], x0[1]); w.y = cvt_pk_bf16(x0[2], x0[3]); w.z = cvt_pk_bf16(x1[0], x1[1]); w.w = cvt_pk_bf16(x1[2], x1[3]); a = __builtin_bit_cast(bf16x8, w); }
            else a = *(const bf16x8*)(srcb + l * 64 + d0);
#pragma unroll
            for (int j = 0; j < 4; ++j) { const bf16x8 bf = *(LAS const bf16x8*)(L + (32 * j + r32) * 1040 + (16 * ks + 8 * hi) * 2); acc[j] = at::mfma32(a, bf, acc[j]); }
        }
    }
    __syncthreads();
    LAS float* P1 = (LAS float*)L;
#pragma unroll
    for (int j = 2; j < 4; ++j)
#pragma unroll
        for (int r = 0; r < 16; ++r) { const int mm = 32 * (wid & 3) + at::crow(r, hi); P1[(g * 128 + mm) * 64 + 32 * (j - 2) + r32] = acc[j][r]; }
    __syncthreads();
    const float* cc = WSP(const float, WS_CCONST) + c * 64;
    bf16* dst = samp ? WSP(bf16, WS_CKS) + ((size_t)(c * 128 + b) * 2 + g) * 8192 : WSP(bf16, WS_CKP) + ((size_t)(c * 8 + b) * 2 + g) * 8192;
#pragma unroll
    for (int j = 0; j < 2; ++j)
#pragma unroll
        for (int r = 0; r < 16; ++r) { const int n = 32 * (wid & 3) + at::crow(r, hi), e = 32 * j + r32;
            const float v = n < 127 ? acc[j][r] + P1[(g * 128 + n + 1) * 64 + e] + cc[e] : 0.f;
            dst[n * 64 + e] = (bf16)(cvt_pk_bf16(v, 0.f) & 0xffffu); }
}
__device__ __forceinline__ f32x4 mfma16(bf16x8 a, bf16x8 b, f32x4 c) { return __builtin_amdgcn_mfma_f32_16x16x32_bf16(a, b, c, 0, 0, 0); }
__device__ __forceinline__ float gelu_tanh(float x) { const float u = 0.7978845608028654f * (x + 0.044715f * x * x * x); const float e = __expf(2.f * u); const float th = 1.f - 2.f / (e + 1.f); return 0.5f * x * (1.f + th); }
__device__ __forceinline__ void s5_unit(Frame& F, int g, int b, bool samp) {
    UNIT_IDS(); const int fr = lane & 15, fq = lane >> 4;
    LAS char* L = (LAS char*)F.lds; LAS char* UL = L; LAS char* LOC = L + 67584;
    const bf16* U = WSP(const bf16, WS_U) + (size_t)g * TT * 16;
    if (!samp) { const bf16* src = U + (size_t)b * 2048 * 16;
#pragma unroll
        for (int i = 0; i < 8; ++i) { const int pid = tid + 512 * i, m = pid >> 5, q = pid & 31; *(LAS u32x4*)(UL + m * 528 + q * 16) = *(const u32x4*)(src + (size_t)pid * 8); } }
    else { const bf16* src = U + (size_t)TP * 16;
#pragma unroll
        for (int i = 0; i < 8; ++i) { const int pid = tid + 512 * i, m = pid >> 5, q = pid & 31; u32x4 v = {0u, 0u, 0u, 0u}; if (q >= 16) v = *(const u32x4*)(src + (size_t)m * 128 + (q - 16) * 8); *(LAS u32x4*)(UL + m * 528 + q * 16) = v; } }
    __syncthreads();
    {
        const bf16* BST = WSP(const bf16, WS_BST) + (size_t)g * 128 * 256 + (size_t)(16 * wid + fr) * 256 + 8 * fq;
        bf16x8 bfr[8];
#pragma unroll
        for (int ks = 0; ks < 8; ++ks) bfr[ks] = *(const bf16x8*)(BST + 32 * ks);
#pragma unroll 2
        for (int mt = 0; mt < 8; ++mt) { f32x4 acc = {0.f, 0.f, 0.f, 0.f};
#pragma unroll
            for (int ks = 0; ks < 8; ++ks) { const bf16x8 a = *(LAS const bf16x8*)(UL + (16 * mt + fr) * 528 + (32 * ks + 8 * fq) * 2); acc = mfma16(a, bfr[ks], acc); }
#pragma unroll
            for (int r = 0; r < 4; ++r) *(LAS float*)(LOC + (16 * mt + 4 * fq + r) * 528 + (16 * wid + fr) * 4) = acc[r]; }
    }
    __syncthreads();
    if (!samp) {
        if (wid == 0) { const float ar = WSP(const float, WS_L16)[(g * 64 + lane) * 2], ai = WSP(const float, WS_L16)[(g * 64 + lane) * 2 + 1];
            float xr = 0.f, xi = 0.f;
            for (int m = 0; m < 128; ++m) { const float lr = *(LAS const float*)(LOC + m * 528 + lane * 4), li = *(LAS const float*)(LOC + m * 528 + 256 + lane * 4);
                __builtin_amdgcn_s_waitcnt(0xc07f);
                *(LAS bf16*)(LOC + m * 528 + lane * 2) = (bf16)(cvt_pk_bf16(xr, 0.f) & 0xffffu); *(LAS bf16*)(LOC + m * 528 + 128 + lane * 2) = (bf16)(cvt_pk_bf16(xi, 0.f) & 0xffffu);
                const float nr = ar * xr - ai * xi + lr, ni = ar * xi + ai * xr + li; xr = nr; xi = ni; }
            F.out[O_SREP + (size_t)(b * 64 + g) * 64 + lane] = xr; F.out[O_SIMP + (size_t)(b * 64 + g) * 64 + lane] = xi; }
    } else {
        const float ar = WSP(const float, WS_L16)[(g * 64 + lane) * 2], ai = WSP(const float, WS_L16)[(g * 64 + lane) * 2 + 1];
        const float br = WSP(const float, WS_L8I)[(g * 64 + lane) * 2], bi = WSP(const float, WS_L8I)[(g * 64 + lane) * 2 + 1];
        for (int m = wid; m < 128; m += 8) { const float lr = *(LAS const float*)(LOC + m * 528 + lane * 4), li = *(LAS const float*)(LOC + m * 528 + 256 + lane * 4);
            const float sr = F.in[5][(size_t)(m * 64 + g) * 64 + lane], si = F.in[6][(size_t)(m * 64 + g) * 64 + lane];
            const float xr = br * sr - bi * si, xi = br * si + bi * sr;
            __builtin_amdgcn_s_waitcnt(0xc07f);
            *(LAS bf16*)(LOC + m * 528 + lane * 2) = (bf16)(cvt_pk_bf16(xr, 0.f) & 0xffffu); *(LAS bf16*)(LOC + m * 528 + 128 + lane * 2) = (bf16)(cvt_pk_bf16(xi, 0.f) & 0xffffu);
            F.out[O_SRES + (size_t)(m * 64 + g) * 64 + lane] = ar * xr - ai * xi + lr; F.out[O_SIMS + (size_t)(m * 64 + g) * 64 + lane] = ar * xi + ai * xr + li; }
    }
    __syncthreads();
    if (!samp || wid >= 4) {
        const bf16* MT = WSP(const bf16, WS_MT) + (size_t)g * 256 * 256 + (size_t)(32 * wid + fr) * 256 + 8 * fq;
        const bf16* CXT = WSP(const bf16, WS_CXT) + (size_t)g * 256 * 128 + (size_t)(32 * wid + fr) * 128 + 8 * fq;
        bf16x8 bm[2][8], bc[2][4];
#pragma unroll
        for (int nt = 0; nt < 2; ++nt) {
#pragma unroll
            for (int ks = 0; ks < 8; ++ks) bm[nt][ks] = *(const bf16x8*)(MT + (size_t)nt * 16 * 256 + 32 * ks);
#pragma unroll
            for (int ks = 0; ks < 4; ++ks) bc[nt][ks] = *(const bf16x8*)(CXT + (size_t)nt * 16 * 128 + 32 * ks); }
        bf16* YG = WSP(bf16, WS_YG);
#pragma unroll 1
        for (int mt = 0; mt < 8; ++mt) { f32x4 acc[2] = {{0.f, 0.f, 0.f, 0.f}, {0.f, 0.f, 0.f, 0.f}};
#pragma unroll
            for (int ks = 0; ks < 8; ++ks) { const bf16x8 a = *(LAS const bf16x8*)(UL + (16 * mt + fr) * 528 + (32 * ks + 8 * fq) * 2); acc[0] = mfma16(a, bm[0][ks], acc[0]); acc[1] = mfma16(a, bm[1][ks], acc[1]); }
#pragma unroll
            for (int ks = 0; ks < 4; ++ks) { const bf16x8 a = *(LAS const bf16x8*)(LOC + (16 * mt + fr) * 528 + (32 * ks + 8 * fq) * 2); acc[0] = mfma16(a, bc[0][ks], acc[0]); acc[1] = mfma16(a, bc[1][ks], acc[1]); }
#pragma unroll
            for (int nt = 0; nt < 2; ++nt)
#pragma unroll
                for (int r = 0; r < 4; ++r) { const int m = 16 * mt + 4 * fq + r, t = 2 * wid + nt;
                    const size_t tok = samp ? (size_t)TP + 8 * m + (t - 8) : (size_t)b * 2048 + 16 * m + t;
                    YG[tok * 1024 + g * 16 + fr] = (bf16)(cvt_pk_bf16(gelu_tanh(acc[nt][r]), 0.f) & 0xffffu); }
        }
    }
}
__device__ __forceinline__ void s5_tables(Frame& F, int g) {
    const int tid = F.tid; LAS char* L = (LAS char*)F.lds;
    LAS float* POW = (LAS float*)L;
    LAS float* BB = (LAS float*)(L + 8704);
    LAS float* KT = (LAS float*)(L + 16896);
    LAS float* CC = (LAS float*)(L + 33280);
    const float* lre = F.in[18] + g * 64; const float* lim = F.in[19] + g * 64;
    const float dt = expf(F.in[25][g]);
    for (int p = tid; p < 64; p += 512) {
        const float lr = lre[p], li = lim[p];
        for (int tau = 0; tau <= 16; ++tau) { const float mg = expf((float)tau * lr * dt); float sn, cs; sincos_d((double)tau * (double)(li * dt), sn, cs); POW[(tau * 64 + p) * 2] = mg * cs; POW[(tau * 64 + p) * 2 + 1] = mg * sn; }
        { const float mg = expf(-8.f * lr * dt); float sn, cs; sincos_d(8.0 * (double)(li * dt), sn, cs); WSP(float, WS_L8I)[(g * 64 + p) * 2] = mg * cs; WSP(float, WS_L8I)[(g * 64 + p) * 2 + 1] = -mg * sn; }
    }
    __syncthreads();
    for (int e = tid; e < 1024; e += 512) { const int p = e >> 4, c = e & 15;
        const float lr = lre[p], li = lim[p], abr = POW[(64 + p) * 2], abi = POW[(64 + p) * 2 + 1], den = lr * lr + li * li, nr = abr - 1.f;
        const float fre = (nr * lr + abi * li) / den, fim = (abi * lr - nr * li) / den;
        const float br = F.in[20][(size_t)(g * 64 + p) * 16 + c], bi = F.in[21][(size_t)(g * 64 + p) * 16 + c];
        BB[e * 2] = fre * br - fim * bi; BB[e * 2 + 1] = fre * bi + fim * br;
        CC[(c * 64 + p) * 2] = F.in[22][(size_t)(g * 16 + c) * 64 + p]; CC[(c * 64 + p) * 2 + 1] = F.in[23][(size_t)(g * 16 + c) * 64 + p]; }
    if (tid < 64) { WSP(float, WS_L16)[(g * 64 + tid) * 2] = POW[(16 * 64 + tid) * 2]; WSP(float, WS_L16)[(g * 64 + tid) * 2 + 1] = POW[(16 * 64 + tid) * 2 + 1]; }
    __syncthreads();
    for (int e = tid; e < 4096; e += 512) { const int tau = e >> 8, c = (e >> 4) & 15, c2 = e & 15; float s = 0.f;
        for (int p = 0; p < 64; ++p) { const float cr = CC[(c * 64 + p) * 2], ci = CC[(c * 64 + p) * 2 + 1], pr = POW[(tau * 64 + p) * 2], pi = POW[(tau * 64 + p) * 2 + 1];
            const float wr = cr * pr - ci * pi, wi = cr * pi + ci * pr; s += wr * BB[(p * 16 + c2) * 2] - wi * BB[(p * 16 + c2) * 2 + 1]; }
        if (tau == 0 && c == c2) s += F.in[24][g * 16 + c];
        KT[e] = s; }
    __syncthreads();
    bf16* MT = WSP(bf16, WS_MT) + (size_t)g * 65536; bf16* BST = WSP(bf16, WS_BST) + (size_t)g * 32768; bf16* CXT = WSP(bf16, WS_CXT) + (size_t)g * 32768;
    for (int e = tid; e < 65536; e += 512) { const int n = e >> 8, k = e & 255, t = n >> 4, c = n & 15, s = k >> 4, c2 = k & 15;
        MT[e] = (bf16)(cvt_pk_bf16(t >= s ? KT[((t - s) * 16 + c) * 16 + c2] : 0.f, 0.f) & 0xffffu); }
    for (int e = tid; e < 32768; e += 512) { const int n = e >> 8, k = e & 255, p = n & 63, s = k >> 4, c2 = k & 15;
        const float pr = POW[((15 - s) * 64 + p) * 2], pi = POW[((15 - s) * 64 + p) * 2 + 1], br = BB[(p * 16 + c2) * 2], bi = BB[(p * 16 + c2) * 2 + 1];
        BST[e] = (bf16)(cvt_pk_bf16(n < 64 ? pr * br - pi * bi : pr * bi + pi * br, 0.f) & 0xffffu); }
    for (int e = tid; e < 32768; e += 512) { const int n = e >> 7, k = e & 127, t = n >> 4, c = n & 15, p = k & 63;
        const float cr = CC[(c * 64 + p) * 2], ci = CC[(c * 64 + p) * 2 + 1], pr = POW[((t + 1) * 64 + p) * 2], pi = POW[((t + 1) * 64 + p) * 2 + 1];
        CXT[e] = (bf16)(cvt_pk_bf16(k < 64 ? cr * pr - ci * pi : -(cr * pi + ci * pr), 0.f) & 0xffffu); }
    __syncthreads();
}
#define XB_TMO      128
#define XB_XCNT(j)  (256  + 64 * (j))
#define XB_XSUB(j)  (1280 + 64 * (j))
#define XB_XGEN(j)  (2304 + 64 * (j))
#define XB_TOP      3328
#define XB_TOPGEN   3392
#define XCD_BAR_WORDS 3456
#define XB_SPIN_CAP (1u << 18)
__device__ __forceinline__ unsigned xb_ld(unsigned* p)              { return __hip_atomic_load(p, __ATOMIC_RELAXED, __HIP_MEMORY_SCOPE_AGENT); }
__device__ __forceinline__ unsigned xb_add(unsigned* p, unsigned v) { return __hip_atomic_fetch_add(p, v, __ATOMIC_RELAXED, __HIP_MEMORY_SCOPE_AGENT); }
__device__ __forceinline__ unsigned xb_xcc_id() { return (unsigned)__builtin_amdgcn_s_getreg((3 << 11) | 20) & 0xFu; }
#define XB_SPIN(cond, bar) do { unsigned _sp = 0; while (cond) { __builtin_amdgcn_s_sleep(1); \
    if ((++_sp & 255u) == 0u) { if (xb_ld(&(bar)[XB_TMO])) break; if (_sp > XB_SPIN_CAP) { atomicAdd(&(bar)[XB_TMO], 1u); break; } } } } while (0)
struct XcdBarrier { unsigned* bar; unsigned x; volatile LAS unsigned* st; };
__device__ __forceinline__ XcdBarrier xcd_barrier_post(unsigned* bar, volatile LAS unsigned* st) {
    XcdBarrier b; b.bar = bar; b.x = xb_xcc_id(); b.st = st;
    if (threadIdx.x == 0) (void)xb_add(&bar[XB_XCNT(b.x)], 1u);
    return b;
}
__device__ __forceinline__ void xcd_barrier_complete(unsigned* bar, unsigned x, unsigned& nloc, unsigned& nx) {
    const unsigned G = gridDim.x * gridDim.y * gridDim.z;
    unsigned sum, cnt, mine, sp = 0u;
    for (;;) {
        sum = 0u; cnt = 0u; mine = 0u;
#pragma unroll
        for (unsigned j = 0; j < 16; ++j) { const unsigned c = xb_ld(&bar[XB_XCNT(j)]); sum += c; cnt += (c > 0u) ? 1u : 0u; mine = (j == x) ? c : mine; }
        if (sum == G) break;
        __builtin_amdgcn_s_sleep(1);
        if ((++sp & 255u) == 0u) { if (xb_ld(&bar[XB_TMO])) break; if (sp > XB_SPIN_CAP) { atomicAdd(&bar[XB_TMO], 1u); break; } }
    }
    nloc = mine > 0u ? mine : 1u; nx = cnt > 0u ? cnt : 1u;
}
__device__ __forceinline__ void xcd_barrier(const XcdBarrier& b) {
    asm volatile("s_waitcnt vmcnt(0)" ::: "memory");
    __syncthreads();
    if (threadIdx.x == 0) {
        unsigned* bar = b.bar;
        __builtin_amdgcn_s_waitcnt(0);
        unsigned nloc = b.st[0], nx = b.st[1];
        if (nloc == 0u) { xcd_barrier_complete(bar, b.x, nloc, nx); b.st[0] = nloc; b.st[1] = nx; }
        const unsigned old = xb_add(&bar[XB_XSUB(b.x)], 1u);
        const unsigned gen = old / nloc;
        if (old + 1u == (gen + 1u) * nloc) {
            __builtin_amdgcn_fence(__ATOMIC_RELEASE, "agent");
            asm volatile("s_waitcnt vmcnt(0)" ::: "memory");
            const unsigned og = xb_add(&bar[XB_TOP], 1u);
            const unsigned tg = og / nx;
            if (og + 1u == (tg + 1u) * nx) xb_add(&bar[XB_TOPGEN], 1u);
            else XB_SPIN(xb_ld(&bar[XB_TOPGEN]) == tg, bar);
            __builtin_amdgcn_fence(__ATOMIC_ACQUIRE, "agent");
            xb_add(&bar[XB_XGEN(b.x)], 1u);
            asm volatile("s_waitcnt vmcnt(0)" ::: "memory");
        } else {
            XB_SPIN(xb_ld(&bar[XB_XGEN(b.x)]) == gen, bar);
            __builtin_amdgcn_fence(__ATOMIC_ACQUIRE, "agent");
            asm volatile("s_waitcnt vmcnt(0)" ::: "memory");
        }
    }
    __syncthreads();
}

__device__ __forceinline__ int l0_src_col(int np) { const int pn = np >> 8, bj = (np >> 7) & 1, wc = (np >> 5) & 3, j = np & 31, rc = 256 * pn + 64 * wc + 32 * bj + j;
    return rc < 2816 ? rc : rc < 3328 ? rc + 24 : rc < 3352 ? rc - 3328 + 2816 : -1; }
__device__ __forceinline__ void p0_transpose_item(const float* W, const float* W2, int K, int N, bf16* WT, int nblk, int kind, const float* gain, LAS float* scr, int item, int lane) {
    const int kb = item / nblk, nb = item % nblk, k0 = 64 * kb, n0 = 32 * nb;
    const int np = n0 + (lane & 31); int sc = np; const float* Ws = W;
    if (kind == 1) sc = l0_src_col(np);
    else if (kind == 2) { const int pn = np >> 8, bj = (np >> 7) & 1, wc = (np >> 5) & 3, j = np & 31; sc = 128 * pn + 32 * wc + j; Ws = bj ? W2 : W; }
#pragma unroll 8
    for (int i = 0; i < 32; ++i) { const int kk = 2 * i + (lane >> 5); float v = 0.f; if (sc >= 0) { v = Ws[(size_t)(k0 + kk) * N + sc]; if (gain) v *= gain[k0 + kk]; } scr[kk * 33 + (lane & 31)] = v; }
    asm volatile("s_waitcnt lgkmcnt(0)" ::: "memory");
    const int c = lane & 7;
#pragma unroll
    for (int j = 0; j < 4; ++j) { const int n = (lane >> 3) + 8 * j; const LAS float* s = scr + (8 * c) * 33 + n;
        u32x4 o; o.x = cvt_pk_bf16(s[0 * 33], s[1 * 33]); o.y = cvt_pk_bf16(s[2 * 33], s[3 * 33]); o.z = cvt_pk_bf16(s[4 * 33], s[5 * 33]); o.w = cvt_pk_bf16(s[6 * 33], s[7 * 33]);
        *(u32x4*)(WT + (size_t)(n0 + n) * K + k0 + 8 * c) = o; }
    asm volatile("s_waitcnt lgkmcnt(0)" ::: "memory");
}
__device__ __forceinline__ void p0_prologue(Frame& F) {
    const int tid = F.tid, lane = F.lane;
    if (blockIdx.x < 64) s5_tables(F, (int)blockIdx.x);
    __syncthreads();
    LAS float* scr = (LAS float*)(F.lds + F.wave * 16384);
    const int gw = (int)blockIdx.x * NWAVES + F.wave, NGW = F.G * NWAVES;
    constexpr int I0 = 16 * 112, IO0 = 16 * 32, I1 = 16 * 64, IG = 16 * 64, IO1 = 16 * 32;
    for (int it = gw; it < I0 + IO0 + I1 + IG + IO1; it += NGW) {
        int r = it;
        if (r < I0) { p0_transpose_item(F.in[9], nullptr, 1024, 3352, WSP(bf16, WS_W0T), 112, 1, F.in[8], scr, r, lane); continue; } r -= I0;
        if (r < IO0) { p0_transpose_item(F.in[10], nullptr, 1024, 1024, WSP(bf16, WS_WO0T), 32, 0, nullptr, scr, r, lane); continue; } r -= IO0;
        if (r < I1) { p0_transpose_item(F.in[17], nullptr, 1024, 2048, WSP(bf16, WS_W1T), 64, 0, F.in[16], scr, r, lane); continue; } r -= I1;
        if (r < IG) { p0_transpose_item(F.in[26], F.in[27], 1024, 1024, WSP(bf16, WS_WGT), 64, 2, nullptr, scr, r, lane); continue; } r -= IG;
        p0_transpose_item(F.in[28], nullptr, 1024, 1024, WSP(bf16, WS_WO1T), 32, 0, nullptr, scr, r, lane);
    }
    for (int m = gw; m < TT; m += NGW) {
        const float* xrow = m < TP ? F.in[0] + (size_t)m * 1024 : F.in[1] + (size_t)(m - TP) * 1024;
        const f32x4* xr = (const f32x4*)xrow + lane; f32x4 v[4]; float s = 0.f;
#pragma unroll
        for (int j = 0; j < 4; ++j) { v[j] = xr[64 * j]; s += (v[j].x * v[j].x + v[j].y * v[j].y) + (v[j].z * v[j].z + v[j].w * v[j].w); }
        const float rstd = 1.f / sqrtf(wave_sum(s) * (1.f / 1024.f) + 1e-6f);
        u32x2* o8 = (u32x2*)(WSP(bf16, WS_H0) + (size_t)m * 1024) + lane;
#pragma unroll
        for (int j = 0; j < 4; ++j) { u32x2 w; w.x = cvt_pk_bf16(v[j].x * rstd, v[j].y * rstd); w.y = cvt_pk_bf16(v[j].z * rstd, v[j].w * rstd); o8[64 * j] = w; }
    }
    const int gt = (int)blockIdx.x * 512 + tid, NGT = F.G * 512;
    for (int e = gt; e < 2056 * 32; e += NGT) { const int pos = e >> 5, i = e & 31; const float inv = (float)exp(-(double)i * (9.210340371976184 / 32.0)); const float ang = (float)pos * inv; float s, c; sincos_d((double)ang, s, c);
        WSP(float, WS_ROPEC)[e] = c; WSP(float, WS_ROPES)[e] = s; }
    for (int e = gt; e < 2 * 128 * 1024; e += NGT) { const int c = e >> 17, n = (e >> 10) & 127, k = e & 1023, r = n >> 6, ee = n & 63, l = k >> 6, d = k & 63;
        WSP(bf16, WS_WCT)[e] = (bf16)(cvt_pk_bf16(F.in[15][(((size_t)c * 32 + 16 * r + l) * 64 + d) * 64 + ee], 0.f) & 0xffffu); }
    for (int o = gw; o < 128; o += NGW) { const int c = o >> 6, e = o & 63; float s = 0.f;
        for (int k = lane; k < 2048; k += 64) s += F.in[14][(size_t)c * 2048 + k] * F.in[15][((size_t)c * 2048 + k) * 64 + e];
        s = wave_sum(s); if (lane == 0) WSP(float, WS_CCONST)[o] = s; }
    { const f32x4* src = (const f32x4*)F.in[3]; f32x4* dst = (f32x4*)(F.out + O_WINS);
      for (int e = gt; e < 128 * 504 * 64; e += NGT) { const int bb = e / (504 * 64), rem = e - bb * (504 * 64); dst[(size_t)bb * 512 * 64 + rem] = __builtin_nontemporal_load(src + (size_t)bb * 512 * 64 + 8 * 64 + rem); } }
}

constexpr int N_PHASES = 9;
#ifndef MK_N_LAUNCHES
#define MK_N_LAUNCHES 9
#endif
struct Args { const void* in[29]; float* out; unsigned char* ws; int ph_lo, ph_hi; };
__global__ void __launch_bounds__(NWAVES * 64, 2) mega_fwd(Args args) {
    extern __shared__ __attribute__((aligned(16))) unsigned char lds[];
    Frame F;
    F.lds = (LAS unsigned char*)lds; F.MISC = (volatile LAS unsigned*)(F.lds + MISC_OFF);
    F.tid = threadIdx.x; F.lane = F.tid & 63; F.wave = __builtin_amdgcn_readfirstlane(F.tid >> 6); F.G = gridDim.x;
#pragma unroll
    for (int i = 0; i < 29; ++i) F.in[i] = (const float*)args.in[i];
    F.ptab = (const int*)args.in[7]; F.out = args.out; F.ws = args.ws; F.ctl = (gu32*)(args.ws + WS_CTL);
    for (int u = F.tid; u < 128; u += NWAVES * 64) F.MISC[u] = 0u;
    __syncthreads();
    XcdBarrier bar; bar.bar = (unsigned*)(F.ctl + CW_BAR); bar.x = 0; bar.st = nullptr;
    if (MK_N_LAUNCHES == 1) bar = xcd_barrier_post((unsigned*)(F.ctl + CW_BAR), F.MISC + 8);
    const int lo = args.ph_lo, hi = args.ph_hi;
#ifdef ONLY_PHASE
#define IN(k) ((k) == ONLY_PHASE && lo <= (k) && (k) < hi)
#else
#define IN(k) (lo <= (k) && (k) < hi)
#endif
#define SEAM(k) do { if (IN(k) && IN((k) + 1)) xcd_barrier(bar); } while (0)
    LAS unsigned char* ring = F.lds;

    if (IN(0)) { p0_prologue(F);
#if defined(DUP_PHASE) && DUP_PHASE == 0
        __syncthreads(); p0_prologue(F);
#endif
    }
    SEAM(0);
    if (IN(1)) {
        pg8::Gemm g{WSP(const pg8::bf16_t, WS_H0), WSP(const pg8::bf16_t, WS_W0T), TT, 3584, 1024}; pg8::StaticOrder S; S.init(TT, 3584, F.G, (int)blockIdx.x);
        pg8::EpiL0 E{WSP(bf16, WS_QA), WSP(bf16, WS_KA), WSP(bf16, WS_VA), WSP(bf16, WS_ZA), WSP(bf16, WS_QN), WSP(bf16, WS_ZB), WSP(bf16, WS_KXP), WSP(bf16, WS_KXS), WSP(float, WS_GATES), F.out,
                     WSP(const float, WS_ROPEC), WSP(const float, WS_ROPES), F.in[12], F.in[13]};
        pg8::gemm_phase<pg8::EpiL0, pg8::StaticOrder, true, true>(ring, g, S, E);
#if defined(DUP_PHASE) && DUP_PHASE == 1
        __syncthreads(); pg8::gemm_phase<pg8::EpiL0, pg8::StaticOrder, true, true>(ring, g, S, E);
#endif
    }
    SEAM(1);
    if (IN(2)) {
#if defined(DUP_PHASE) && DUP_PHASE == 2
        for (int rep = 0; rep < 2; ++rep)
        for (;;) { const int it = wq_next(F, rep ? 4 : 0); if (it >= 256 + 16 + 512 + 512) break;
#else
        for (;;) { const int it = wq_next(F, 0); if (it >= 256 + 16 + 512 + 512) break;
#endif
            if (it < 256) cmp_unit(F, it >> 1, it & 1, true);
            else if (it < 272) cmp_unit(F, (it - 256) >> 1, (it - 256) & 1, false);
            else if (it < 784) { const int u = it - 272; ret_r1_unit(F, u >> 6, (u >> 4) & 3, u & 15); }
            else { const int u = it - 784; ret_sample_unit(F, u >> 2, u & 3); } }
    }
    SEAM(2);
    if (IN(3)) {
#if defined(DUP_PHASE) && DUP_PHASE == 3
        for (int rep = 0; rep < 2; ++rep)
        for (;;) { const int it = wq_next(F, rep ? 5 : 1); if (it >= 256 + 256 + 256 + 512) break;
#else
        for (;;) { const int it = wq_next(F, 1); if (it >= 256 + 256 + 256 + 512) break;
#endif
#if defined(DUP_PHASE) && DUP_PHASE == 3 && defined(DUP3_KIND)
            const int kmask = rep ? DUP3_KIND : 7;
#else
            const int kmask = 7;
#endif
            if (it < 256 || (it >= 512 && it < 768)) { const int u = it < 256 ? it : it - 256; const int c = 31 - (u >> 4), bg = u & 15;
                if (kmask & 1) nsa_prompt_unit(F, bg >> 1, bg & 1, c); }
            else if (it < 512) { const int u = it - 256;
                if (kmask & 2) nsa_sample_unit(F, u >> 1, u & 1); }
            else { const int u = it - 768;
                if (kmask & 4) ret_r2_unit(F, u >> 6, (u >> 4) & 3, u & 15); } }
    }
    SEAM(3);
    if (IN(4)) {
        pg8::Gemm g{WSP(const pg8::bf16_t, WS_MIX), WSP(const pg8::bf16_t, WS_WO0T), TT, 1024, 1024}; pg8::StaticOrder S; S.init(TT, 1024, F.G, (int)blockIdx.x);
        pg8::EpiOut0 E{F.in[0], F.in[1], F.out + O_Y, WSP(bf16, WS_Y0B), (float*)(F.ctl + CW_SS)};
        pg8::gemm_phase<pg8::EpiOut0, pg8::StaticOrder, true, true>(ring, g, S, E);
    }
    SEAM(4);
    if (IN(5)) {
        pg8::Gemm g{WSP(const pg8::bf16_t, WS_Y0B), WSP(const pg8::bf16_t, WS_W1T), TT, 2048, 1024}; pg8::StaticOrder S; S.init(TT, 2048, F.G, (int)blockIdx.x);
        pg8::EpiL1 E{(const float*)(F.ctl + CW_SS), WSP(bf16, WS_U), WSP(bf16, WS_Z1)};
        pg8::gemm_phase<pg8::EpiL1, pg8::StaticOrder, true, true>(ring, g, S, E);
#if defined(DUP_PHASE) && DUP_PHASE == 5
        __syncthreads(); pg8::gemm_phase<pg8::EpiL1, pg8::StaticOrder, true, true>(ring, g, S, E);
#endif
    }
    SEAM(5);
    if (IN(6)) {
#if defined(DUP_PHASE) && DUP_PHASE == 6
        for (int rep = 0; rep < 2; ++rep)
        for (;;) { const int it = wq_next(F, rep ? 6 : 2); if (it >= 576) break;
#else
        for (;;) { const int it = wq_next(F, 2); if (it >= 576) break;
#endif
            if (it < 512) s5_unit(F, it & 63, it >> 6, false); else s5_unit(F, it - 512, 0, true); }
    }
    SEAM(6);
    if (IN(7)) {
        pg8::Gemm g{WSP(const pg8::bf16_t, WS_YG), WSP(const pg8::bf16_t, WS_WGT), TT, 2048, 1024}; pg8::StaticOrder S; S.init(TT, 2048, F.G, (int)blockIdx.x);
        pg8::EpiGLU E{WSP(const bf16, WS_Z1), WSP(bf16, WS_V1)};
        pg8::gemm_phase<pg8::EpiGLU, pg8::StaticOrder, true, true>(ring, g, S, E);
#if defined(DUP_PHASE) && DUP_PHASE == 7
        __syncthreads(); pg8::gemm_phase<pg8::EpiGLU, pg8::StaticOrder, true, true>(ring, g, S, E);
#endif
    }
    SEAM(7);
    if (IN(8)) {
        pg8::Gemm g{WSP(const pg8::bf16_t, WS_V1), WSP(const pg8::bf16_t, WS_WO1T), TT, 1024, 1024}; pg8::StaticOrder S; S.init(TT, 1024, F.G, (int)blockIdx.x);
        pg8::EpiFinal E{F.out + O_Y};
        pg8::gemm_phase<pg8::EpiFinal, pg8::StaticOrder, true, true>(ring, g, S, E);
    }
#undef IN
#undef SEAM
}

extern "C" void kernel_launch(void* const* d_in, const int* in_sizes, int n_in, void* d_out, int out_size, void* d_ws, size_t ws_size, hipStream_t stream) {
    static int grid = 0;
    if (grid == 0) {
        if (n_in != 29 || out_size != (int)O_END || ws_size < WS_END) { fprintf(stderr, "kernel_launch: unexpected shapes (n_in %d, out %d, ws %zu); nothing launched\n", n_in, out_size, ws_size); grid = -1; return; }
        int dev = 0, cus = 0, per_cu = 0;
        if (hipGetDevice(&dev) != hipSuccess || hipDeviceGetAttribute(&cus, hipDeviceAttributeMultiprocessorCount, dev) != hipSuccess) { grid = -1; return; }
        if (hipFuncSetAttribute((const void*)mega_fwd, hipFuncAttributeMaxDynamicSharedMemorySize, LDS_BYTES) != hipSuccess) { fprintf(stderr, "kernel_launch: hipFuncSetAttribute failed\n"); grid = -1; return; }
        if (hipOccupancyMaxActiveBlocksPerMultiprocessor(&per_cu, (const void*)mega_fwd, NWAVES * 64, LDS_BYTES) != hipSuccess || per_cu < 1) { fprintf(stderr, "kernel_launch: occupancy query says %d\n", per_cu); per_cu = 1; }
        (void)hipGetLastError();
        grid = cus;
    }
    if (grid < 0) return;
    (void)hipMemsetAsync((char*)d_ws + WS_CTL, 0, CTL_ZERO_BYTES, stream);
    Args a{};
    for (int i = 0; i < 29; ++i) a.in[i] = d_in[i];
    a.out = (float*)d_out; a.ws = (unsigned char*)d_ws;
    if (MK_N_LAUNCHES == 1) {
        a.ph_lo = 0; a.ph_hi = N_PHASES;
        void* kargs[] = {&a};
        hipError_t e = hipLaunchCooperativeKernel((const void*)mega_fwd, dim3(grid), dim3(NWAVES * 64), kargs, LDS_BYTES, stream);
        if (e != hipSuccess) fprintf(stderr, "kernel_launch: cooperative launch failed: %s (grid %d)\n", hipGetErrorString(e), grid);
    } else {
        for (int p = 0; p < N_PHASES; ++p) { a.ph_lo = p; a.ph_hi = p + 1; hipLaunchKernelGGL(mega_fwd, dim3(grid), dim3(NWAVES * 64), LDS_BYTES, stream, a); }
    }
}
```

```cpp
#include <hip/hip_runtime.h>
#include <cstdio>
#include <cstdint>
#include <cmath>
#ifndef MK_N_LAUNCHES
#define MK_N_LAUNCHES 1
#endif
namespace pg8 {
#define PG8_LAS __attribute__((address_space(3)))
typedef unsigned short bf16_t;
typedef short bf16x8 __attribute__((ext_vector_type(8)));
typedef float f32x4 __attribute__((ext_vector_type(4)));
typedef unsigned u32x4 __attribute__((ext_vector_type(4)));
constexpr int BM = 256, BK = 64, HALF = 128, HTB = HALF * BK * 2  , STAGE_BYTES = 8 * HTB, NXCD = 8, WGM = 8;

__host__ __device__ __forceinline__ int lds_byte(int r, int c) { const int st = (r >> 4) * 2 + (c >> 5), rr = r & 15, cc = c & 31, ob = rr * 64 + cc * 2; return st * 1024 + (ob ^ (((ob >> 9) & 1) << 5)); }
__host__ __device__ __forceinline__ void stage_rc(int b, int& R, int& C) { const int st = b / 1024, sb = b % 1024, swz = sb ^ (((sb >> 9) & 1) << 5); R = (st >> 1) * 16 + swz / 64; C = (st & 1) * 32 + (swz % 64) / 2; }
__host__ __device__ __forceinline__ int perm32(int rho) { const int n = rho >> 4, i = rho & 15; return 8 * (i >> 2) + 4 * n + (i & 3); }

struct Unit { int pm, pn; };
struct Gemm { const bf16_t* A; const bf16_t* Bt; int M, N, K; };

struct StaticOrder {
    int nM, nN, nwg, G, c;
    __host__ __device__ void init(int M, int N, int G_, int c_) { nM = M / BM; nN = N / BM; nwg = nM * nN; G = G_; c = c_; }
    __host__ __device__ bool next(int i, Unit& u) const {
        const long L = (long)i * G + c; if (L >= nwg) return false;
        int wgid = (int)L; { const int q = nwg / NXCD, r = nwg % NXCD, xcd = wgid % NXCD, off = wgid / NXCD; wgid = (xcd < r ? xcd * (q + 1) : r * (q + 1) + (xcd - r) * q) + off; }
        const int nig = WGM * nN, gid = wgid / nig, fm = gid * WGM, gsz = (nM - fm) < WGM ? (nM - fm) : WGM;
        u.pm = fm + ((wgid % nig) % gsz); u.pn = (wgid % nig) / gsz; return true;
    }
    __device__ __forceinline__ void a_ready(const Unit&) const {}
    __device__ __forceinline__ void done(const Unit&) const {}
};

typedef float f32x2 __attribute__((ext_vector_type(2)));
typedef __bf16 bf16x2_t __attribute__((ext_vector_type(2)));
__device__ __forceinline__ unsigned cvt_pk_bf16(float lo, float hi) { f32x2 v = {lo, hi}; bf16x2_t b = __builtin_convertvector(v, bf16x2_t); return __builtin_bit_cast(unsigned, b); }
__device__ __forceinline__ u32x4 pack8(const float* v) { u32x4 w; w.x = cvt_pk_bf16(v[0], v[1]); w.y = cvt_pk_bf16(v[2], v[3]); w.z = cvt_pk_bf16(v[4], v[5]); w.w = cvt_pk_bf16(v[6], v[7]); return w; }
__device__ __forceinline__ float bf2f(unsigned short h) { return __uint_as_float(((unsigned)h) << 16); }
__device__ __forceinline__ void unpack8(u32x4 w, float* v) { v[0] = __uint_as_float(w.x << 16); v[1] = __uint_as_float(w.x & 0xffff0000u); v[2] = __uint_as_float(w.y << 16); v[3] = __uint_as_float(w.y & 0xffff0000u);
    v[4] = __uint_as_float(w.z << 16); v[5] = __uint_as_float(w.z & 0xffff0000u); v[6] = __uint_as_float(w.w << 16); v[7] = __uint_as_float(w.w & 0xffff0000u); }
__device__ __forceinline__ float sigmoidf_(float x) { return 1.f / (1.f + __expf(-x)); }
__device__ __forceinline__ float siluf_(float x) { return x / (1.f + __expf(-x)); }

constexpr float QSCALE = 0.125f * 1.4426950408889634f;
constexpr size_t O_Y = 0, O_RETP = 17825792, O_RETS = 18087936, O_KVP = 22282240, O_KVS = 30670848, O_WINP = 31195136, O_WINS = 32243712,
                 O_SREP = 49020928, O_SIMP = 49053696, O_SRES = 49086464, O_SIMS = 49610752, O_END = 50135040;

struct EpiL0 {
    static constexpr bool PERM = true, AFTER_DRAIN = false;
    bf16_t *QA, *KA, *VA, *ZA, *QN, *ZB, *KXP, *KXS; float *GATES, *out; const float *ropeC, *ropeS, *qnorm, *knorm;
    __device__ __forceinline__ void operator()(const f32x4 (&acc)[2][2][4][2], const Unit& u, int wr, int wc, int fr, int fq) const {
        const int pn = u.pn; const bool samp = u.pm >= 64; const int d0 = 8 * fq;
        bool do_norm = false, do_rope = false, gates = false; float scale = 1.f; const float* nw = nullptr;
        bf16_t* bdst = nullptr; int bpitch = 0, bmode = 0, fmode = 0, type = 0, g = 0;
        if (pn == 0) { do_rope = true; bdst = QA + wc * 64; bpitch = 256; }
        else if (pn == 1) { do_rope = true; scale = 0.125f; bdst = KA + wc * 64; bpitch = 256; }
        else if (pn < 4) { bdst = VA + (pn - 2) * 256 + wc * 64; bpitch = 512; }
        else if (pn < 6) { bdst = ZA + (pn - 4) * 256 + wc * 64; bpitch = 512; }
        else if (pn < 8) { do_norm = true; do_rope = true; nw = qnorm; scale = QSCALE; bdst = QN + (pn - 6) * 256 + wc * 64; bpitch = 512; }
        else if (pn < 11) { const int slot = (pn - 8) * 4 + wc; type = slot >> 1; g = slot & 1; if (!(type & 1)) { do_norm = true; do_rope = true; nw = knorm + (type >> 1) * 64; }
            bmode = 1; bpitch = 64; bdst = samp ? KXS + (size_t)type * 131072 + g * 512 : KXP + (size_t)type * 2097152 + (size_t)g * 131072; fmode = type < 4 ? 1 : 2; }
        else if (pn < 13) { bdst = ZB + (pn - 11) * 256 + wc * 64; bpitch = 512; }
        else { gates = true; }
        float nwl[8], nwh[8];
        if (do_norm) {
#pragma unroll
            for (int j = 0; j < 8; ++j) { nwl[j] = nw[d0 + j]; nwh[j] = nw[32 + d0 + j]; } }
#pragma unroll
        for (int ai = 0; ai < 2; ++ai)
#pragma unroll
            for (int m = 0; m < 4; ++m) {
                const int row = u.pm * BM + ai * HALF + wr * 64 + m * 16 + fr;
                int b, t, pos; if (!samp) { b = row >> 11; t = row & 2047; pos = t; } else { const int rs = row - 16384; b = rs >> 3; t = rs & 7; pos = 2048 + t; }
                float lo[8], hi[8];
#pragma unroll
                for (int n = 0; n < 2; ++n)
#pragma unroll
                    for (int i = 0; i < 4; ++i) { lo[4 * n + i] = acc[ai][0][m][n][i]; hi[4 * n + i] = acc[ai][1][m][n][i]; }
                if (gates) {
                    if (wc == 0 && fq < 3) {
                        f32x4 a, c;
#pragma unroll
                        for (int i = 0; i < 4; ++i) { a[i] = sigmoidf_(lo[i]); c[i] = sigmoidf_(lo[4 + i]); }
                        *(f32x4*)(GATES + (size_t)row * 24 + d0) = a; *(f32x4*)(GATES + (size_t)row * 24 + d0 + 4) = c; }
                    continue; }
                if (do_norm) {
                    float ss = 0.f;
#pragma unroll
                    for (int j = 0; j < 8; ++j) ss += lo[j] * lo[j] + hi[j] * hi[j];
                    ss += __shfl_xor(ss, 16); ss += __shfl_xor(ss, 32);
                    const float rstd = __builtin_amdgcn_rsqf(ss * (1.f / 64.f) + 1e-6f);
#pragma unroll
                    for (int j = 0; j < 8; ++j) { lo[j] *= rstd * nwl[j]; hi[j] *= rstd * nwh[j]; } }
                if (do_rope) {
                    const f32x4 c0 = *(const f32x4*)(ropeC + pos * 32 + d0), c1 = *(const f32x4*)(ropeC + pos * 32 + d0 + 4);
                    const f32x4 s0 = *(const f32x4*)(ropeS + pos * 32 + d0), s1 = *(const f32x4*)(ropeS + pos * 32 + d0 + 4);
#pragma unroll
                    for (int j = 0; j < 8; ++j) { const float c = j < 4 ? c0[j & 3] : c1[j & 3], s = j < 4 ? s0[j & 3] : s1[j & 3]; const float x1 = lo[j], x2 = hi[j]; lo[j] = x1 * c - x2 * s; hi[j] = x2 * c + x1 * s; } }
                if (fmode) {
                    float* fp = nullptr;
                    if (fmode == 1) fp = out + (samp ? O_KVS : O_KVP) + (size_t)(samp ? row - 16384 : row) * 512 + type * 128 + g * 64;
                    else if (samp) fp = out + O_WINS + ((size_t)(b * 512 + 504 + t) * 2 + (type - 4)) * 128 + g * 64;
                    else if (t >= 1536) fp = out + O_WINP + ((size_t)(b * 512 + t - 1536) * 2 + (type - 4)) * 128 + g * 64;
                    if (fp) { *(f32x4*)(fp + d0) = (f32x4){lo[0], lo[1], lo[2], lo[3]}; *(f32x4*)(fp + d0 + 4) = (f32x4){lo[4], lo[5], lo[6], lo[7]};
                              *(f32x4*)(fp + 32 + d0) = (f32x4){hi[0], hi[1], hi[2], hi[3]}; *(f32x4*)(fp + 32 + d0 + 4) = (f32x4){hi[4], hi[5], hi[6], hi[7]}; } }
                if (scale != 1.f) {
#pragma unroll
                    for (int j = 0; j < 8; ++j) { lo[j] *= scale; hi[j] *= scale; } }
                const size_t ridx = bmode ? (samp ? (size_t)(b * 16 + t) : (size_t)(b * 4096 + t)) : (size_t)row;
                bf16_t* bp = bdst + ridx * bpitch;
                *(u32x4*)(bp + d0) = pack8(lo); *(u32x4*)(bp + 32 + d0) = pack8(hi);
            }
    }
};

struct EpiOut0 {
    static constexpr bool PERM = true, AFTER_DRAIN = false;
    const float *xp, *xs; float* y; bf16_t* yb; float* ss;
    __device__ __forceinline__ void operator()(const f32x4 (&acc)[2][2][4][2], const Unit& u, int wr, int wc, int fr, int fq) const {
        const float* xb = u.pm >= 64 ? xs - (size_t)16384 * 1024 : xp;
        const int c0 = u.pn * BM + wc * 32 + 8 * fq;
#pragma unroll
        for (int ai = 0; ai < 2; ++ai)
#pragma unroll
            for (int m = 0; m < 4; ++m) {
                const int row = u.pm * BM + ai * HALF + wr * 64 + m * 16 + fr; float sq = 0.f;
#pragma unroll
                for (int bj = 0; bj < 2; ++bj) {
                    const size_t off = (size_t)row * 1024 + c0 + bj * HALF;
                    const f32x4 x0 = *(const f32x4*)(xb + off), x1 = *(const f32x4*)(xb + off + 4);
                    const f32x4 v0 = acc[ai][bj][m][0] + x0, v1 = acc[ai][bj][m][1] + x1;
                    *(f32x4*)(y + off) = v0; *(f32x4*)(y + off + 4) = v1;
                    float v[8] = {v0[0], v0[1], v0[2], v0[3], v1[0], v1[1], v1[2], v1[3]};
#pragma unroll
                    for (int j = 0; j < 8; ++j) sq += v[j] * v[j];
                    *(u32x4*)(yb + off) = pack8(v); }
                sq += __shfl_xor(sq, 16); sq += __shfl_xor(sq, 32);
                if (fq == 0) atomicAdd(ss + row, sq);
            }
    }
};

struct EpiL1 {
    static constexpr bool PERM = true, AFTER_DRAIN = false;
    const float* ss; bf16_t *U, *Z1;
    __device__ __forceinline__ void operator()(const f32x4 (&acc)[2][2][4][2], const Unit& u, int wr, int wc, int fr, int fq) const {
        const int c0 = u.pn * BM + wc * 32 + 8 * fq;
#pragma unroll
        for (int ai = 0; ai < 2; ++ai)
#pragma unroll
            for (int m = 0; m < 4; ++m) {
                const int row = u.pm * BM + ai * HALF + wr * 64 + m * 16 + fr;
                const float rstd = __builtin_amdgcn_rsqf(ss[row] * (1.f / 1024.f) + 1e-6f);
#pragma unroll
                for (int bj = 0; bj < 2; ++bj) {
                    const int c = c0 + bj * HALF; float v[8];
#pragma unroll
                    for (int i = 0; i < 4; ++i) { v[i] = acc[ai][bj][m][0][i] * rstd; v[4 + i] = acc[ai][bj][m][1][i] * rstd; }
                    bf16_t* p = c < 1024 ? U + ((size_t)(c >> 4) * 17408 + row) * 16 + (c & 15) : Z1 + (size_t)row * 1024 + (c - 1024);
                    *(u32x4*)p = pack8(v); }
            }
    }
};

struct EpiGLU {
    static constexpr bool PERM = true, AFTER_DRAIN = false;
    const bf16_t* Z1; bf16_t* V1;
    __device__ __forceinline__ void operator()(const f32x4 (&acc)[2][2][4][2], const Unit& u, int wr, int wc, int fr, int fq) const {
        const int c = u.pn * 128 + wc * 32 + 8 * fq;
#pragma unroll
        for (int ai = 0; ai < 2; ++ai)
#pragma unroll
            for (int m = 0; m < 4; ++m) {
                const int row = u.pm * BM + ai * HALF + wr * 64 + m * 16 + fr;
                float z[8]; unpack8(*(const u32x4*)(Z1 + (size_t)row * 1024 + c), z); float v[8];
#pragma unroll
                for (int i = 0; i < 4; ++i) { v[i] = acc[ai][0][m][0][i] * sigmoidf_(acc[ai][1][m][0][i]) * siluf_(z[i]); v[4 + i] = acc[ai][0][m][1][i] * sigmoidf_(acc[ai][1][m][1][i]) * siluf_(z[4 + i]); }
                *(u32x4*)(V1 + (size_t)row * 1024 + c) = pack8(v);
            }
    }
};

struct EpiFinal {
    static constexpr bool PERM = true, AFTER_DRAIN = false;
    float* y;
    __device__ __forceinline__ void operator()(const f32x4 (&acc)[2][2][4][2], const Unit& u, int wr, int wc, int fr, int fq) const {
        const int c0 = u.pn * BM + wc * 32 + 8 * fq;
#pragma unroll
        for (int ai = 0; ai < 2; ++ai)
#pragma unroll
            for (int m = 0; m < 4; ++m) {
                const int row = u.pm * BM + ai * HALF + wr * 64 + m * 16 + fr;
#pragma unroll
                for (int bj = 0; bj < 2; ++bj) { float* p = y + (size_t)row * 1024 + c0 + bj * HALF;
                    *(f32x4*)p = *(const f32x4*)p + acc[ai][bj][m][0]; *(f32x4*)(p + 4) = *(const f32x4*)(p + 4) + acc[ai][bj][m][1]; }
            }
    }
};

template <class Epi, class Sched, bool ALIGN_EPI = false, bool SP2 = false>
__device__ __forceinline__ void gemm_phase(PG8_LAS unsigned char* lds, const Gemm g, const Sched& S, const Epi& E) {
    const int tid = threadIdx.x, wid = __builtin_amdgcn_readfirstlane(tid >> 6), lane = tid & 63, wr = wid >> 2, wc = wid & 3, fr = lane & 15, fq = lane >> 4;
    const int K = g.K, nt = K / BK;
    unsigned voffA[2], voffB[2];
#pragma unroll
    for (int i = 0; i < 2; ++i) { int R, C; stage_rc(tid * 16 + i * 8192, R, C); const int Rb = Epi::PERM ? ((R & ~31) + perm32(R & 31)) : R;
        voffA[i] = (unsigned)(R * K + C) * 2u; voffB[i] = (unsigned)(Rb * K + C) * 2u; }
    const size_t kstep = (size_t)(BK * 2);
    const size_t hstep = (size_t)HALF * K * 2;
    const size_t tstep = 2 * hstep;
    const unsigned ldsw = (unsigned)wid * 1024u;
    const int aoff = lds_byte(wr * 64 + fr, fq * 8), boff = lds_byte(wc * 32 + fr, fq * 8);
#define PG8_SA(b, h) (((b) * 2 + (h)) * HTB)
#define PG8_SB(b, h) ((4 + (b) * 2 + (h)) * HTB)
#define PG8_STAGE(bufoff, gbase, voff) do { _Pragma("unroll") for (int _i = 0; _i < 2; ++_i) \
        __builtin_amdgcn_global_load_lds((const unsigned*)((const char*)(gbase) + (voff)[_i]), (PG8_LAS unsigned*)(lds + (bufoff) + ldsw + _i * 8192), 16, 0, 0); } while (0)
#define PG8_LDA(dst, b, h) do { _Pragma("unroll") for (int m = 0; m < 4; ++m) _Pragma("unroll") for (int k = 0; k < 2; ++k) dst[m][k] = *(const PG8_LAS bf16x8*)(lds + PG8_SA(b, h) + aoff + m * 2048 + k * 1024); } while (0)
#define PG8_LDB(dst, b, h) do { _Pragma("unroll") for (int n = 0; n < 2; ++n) _Pragma("unroll") for (int k = 0; k < 2; ++k) dst[n][k] = *(const PG8_LAS bf16x8*)(lds + PG8_SB(b, h) + boff + n * 2048 + k * 1024); } while (0)
#define PG8_MMA(ai, bj, At, Bt) do { __builtin_amdgcn_s_setprio(1); _Pragma("unroll") for (int m = 0; m < 4; ++m) _Pragma("unroll") for (int n = 0; n < 2; ++n) _Pragma("unroll") for (int k = 0; k < 2; ++k) \
        acc[ai][bj][m][n] = __builtin_amdgcn_mfma_f32_16x16x32_bf16(Bt[n][k], At[m][k], acc[ai][bj][m][n], 0, 0, 0); __builtin_amdgcn_s_setprio(0); } while (0)
#define PG8_WAIT_V(n) asm volatile("s_waitcnt vmcnt(" #n ")" ::: "memory")
#define PG8_WAIT_L(n) asm volatile("s_waitcnt lgkmcnt(" #n ")" ::: "memory")
#define PG8_BAR __builtin_amdgcn_s_barrier()
#define PG8_SCHED __builtin_amdgcn_sched_barrier(0)
    Unit cur, nxt; int ui = 0;
    if (!S.next(0, cur)) return;
    f32x4 acc[2][2][4][2];
#pragma unroll
    for (int a = 0; a < 2; ++a)
#pragma unroll
        for (int b = 0; b < 2; ++b)
#pragma unroll
            for (int m = 0; m < 4; ++m)
#pragma unroll
                for (int n = 0; n < 2; ++n) acc[a][b][m][n] = (f32x4){0.f, 0.f, 0.f, 0.f};
    bf16x8 At[4][2], B0[2][2], B1[2][2];
    const char* cA = (const char*)g.A + (size_t)cur.pm * tstep; const char* cB = (const char*)g.Bt + (size_t)cur.pn * tstep;
    S.a_ready(cur);
    if constexpr (SP2) {
        PG8_STAGE(PG8_SB(0, 0), cB, voffB); PG8_STAGE(PG8_SB(0, 1), cB + hstep, voffB); PG8_STAGE(PG8_SA(0, 0), cA, voffA); PG8_STAGE(PG8_SA(0, 1), cA + hstep, voffA);
        if (wr == 1) PG8_BAR;
        PG8_WAIT_V(2); PG8_BAR;
        PG8_STAGE(PG8_SB(1, 0), cB + kstep, voffB); PG8_STAGE(PG8_SA(1, 0), cA + kstep, voffA); PG8_STAGE(PG8_SB(1, 1), cB + hstep + kstep, voffB);
        PG8_WAIT_V(6); PG8_BAR;
    } else {
        PG8_STAGE(PG8_SB(0, 0), cB, voffB); PG8_STAGE(PG8_SA(0, 0), cA, voffA); PG8_STAGE(PG8_SB(0, 1), cB + hstep, voffB); PG8_STAGE(PG8_SA(0, 1), cA + hstep, voffA);
        if (wr == 1) PG8_BAR;
        PG8_WAIT_V(4); PG8_BAR;
        PG8_STAGE(PG8_SB(1, 0), cB + kstep, voffB); PG8_STAGE(PG8_SA(1, 0), cA + kstep, voffA); PG8_STAGE(PG8_SB(1, 1), cB + hstep + kstep, voffB);
        PG8_WAIT_V(6); PG8_BAR;
    }
    for (;;) {
        const bool has_next = S.next(ui + 1, nxt);
        const char* nA = has_next ? (const char*)g.A + (size_t)nxt.pm * tstep : cA; const char* nB = has_next ? (const char*)g.Bt + (size_t)nxt.pn * tstep : cB;
        for (int t = 0; t < nt; t += 2) {
            const bool last = (t == nt - 2);
            const char* a1 = cA + (size_t)(t + 1) * kstep;
            const char* a2 = last ? nA : cA + (size_t)(t + 2) * kstep; const char* b2 = last ? nB : cB + (size_t)(t + 2) * kstep;
            const char* a3 = a2 + kstep; const char* b3 = b2 + kstep;
            if (last && has_next) S.a_ready(nxt);
            if constexpr (SP2) {
            PG8_LDB(B0, 0, 0); PG8_LDB(B1, 0, 1); PG8_SCHED; PG8_LDA(At, 0, 0); PG8_STAGE(PG8_SA(1, 1), a1 + hstep, voffA);
            PG8_WAIT_V(8); PG8_WAIT_L(0); PG8_BAR; PG8_MMA(0, 0, At, B0); PG8_MMA(0, 1, At, B1); PG8_BAR; PG8_SCHED;
            PG8_LDA(At, 0, 1); PG8_STAGE(PG8_SB(0, 0), b2, voffB); PG8_STAGE(PG8_SB(0, 1), b2 + hstep, voffB); PG8_STAGE(PG8_SA(0, 0), a2, voffA);
            PG8_WAIT_V(8); PG8_WAIT_L(0); PG8_BAR; PG8_MMA(1, 0, At, B0); PG8_MMA(1, 1, At, B1); PG8_BAR; PG8_SCHED;
            PG8_LDB(B0, 1, 0); PG8_LDB(B1, 1, 1); PG8_SCHED; PG8_LDA(At, 1, 0); PG8_STAGE(PG8_SA(0, 1), a2 + hstep, voffA);
            PG8_WAIT_V(8); PG8_WAIT_L(0); PG8_BAR; PG8_MMA(0, 0, At, B0); PG8_MMA(0, 1, At, B1); PG8_BAR; PG8_SCHED;
            PG8_LDA(At, 1, 1); PG8_STAGE(PG8_SB(1, 0), b3, voffB); PG8_STAGE(PG8_SB(1, 1), b3 + hstep, voffB); PG8_STAGE(PG8_SA(1, 0), a3, voffA);
            PG8_WAIT_V(8); PG8_WAIT_L(0); PG8_BAR; PG8_MMA(1, 0, At, B0); PG8_MMA(1, 1, At, B1); PG8_BAR; PG8_SCHED;
            } else {
            PG8_LDB(B0, 0, 0); PG8_SCHED; PG8_LDA(At, 0, 0); PG8_STAGE(PG8_SA(1, 1), a1 + hstep, voffA);
            PG8_WAIT_L(8); PG8_BAR; PG8_WAIT_L(0); PG8_MMA(0, 0, At, B0); PG8_BAR; PG8_SCHED;
            PG8_LDB(B1, 0, 1); PG8_STAGE(PG8_SB(0, 0), b2, voffB);
            PG8_BAR; PG8_WAIT_L(0); PG8_MMA(0, 1, At, B1); PG8_BAR;
            PG8_LDA(At, 0, 1); PG8_STAGE(PG8_SA(0, 0), a2, voffA);
            PG8_BAR; PG8_WAIT_L(0); PG8_MMA(1, 0, At, B0); PG8_BAR; PG8_SCHED;
            PG8_STAGE(PG8_SB(0, 1), b2 + hstep, voffB);
            PG8_WAIT_V(6); PG8_BAR; PG8_MMA(1, 1, At, B1); PG8_BAR;
            PG8_LDB(B0, 1, 0); PG8_SCHED; PG8_LDA(At, 1, 0); PG8_STAGE(PG8_SA(0, 1), a2 + hstep, voffA);
            PG8_WAIT_L(8); PG8_BAR; PG8_WAIT_L(0); PG8_MMA(0, 0, At, B0); PG8_BAR; PG8_SCHED;
            PG8_LDB(B1, 1, 1); PG8_STAGE(PG8_SB(1, 0), b3, voffB);
            PG8_BAR; PG8_WAIT_L(0); PG8_MMA(0, 1, At, B1); PG8_BAR;
            PG8_LDA(At, 1, 1); PG8_STAGE(PG8_SA(1, 0), a3, voffA);
            PG8_BAR; PG8_WAIT_L(0); PG8_MMA(1, 0, At, B0); PG8_BAR; PG8_SCHED;
            PG8_STAGE(PG8_SB(1, 1), b3 + hstep, voffB);
            PG8_WAIT_V(6); PG8_BAR; PG8_MMA(1, 1, At, B1); PG8_BAR;
            }
        }
        if constexpr (ALIGN_EPI) { if (wr == 0) PG8_BAR; }
        if constexpr (!Epi::AFTER_DRAIN) { E(acc, cur, wr, wc, fr, fq); S.done(cur); }
        if (!has_next) break;
#pragma unroll
        for (int a = 0; a < 2; ++a)
#pragma unroll
            for (int b = 0; b < 2; ++b)
#pragma unroll
                for (int m = 0; m < 4; ++m)
#pragma unroll
                    for (int n = 0; n < 2; ++n) acc[a][b][m][n] = (f32x4){0.f, 0.f, 0.f, 0.f};
        cur = nxt; cA = nA; cB = nB; ++ui;
        if constexpr (ALIGN_EPI) { if (wr == 1) PG8_BAR; }
    }
    PG8_WAIT_V(0);
    if constexpr (!ALIGN_EPI) { if (wr == 0) PG8_BAR; }
    PG8_BAR;
    if constexpr (Epi::AFTER_DRAIN) { E.fused(acc, cur, wr, wc, fr, fq, lds, wid, lane); S.done(cur); }
#undef PG8_SA
#undef PG8_SB
#undef PG8_STAGE
#undef PG8_LDA
#undef PG8_LDB
#undef PG8_MMA
#undef PG8_WAIT_V
#undef PG8_WAIT_L
#undef PG8_BAR
#undef PG8_SCHED
}
}
#define LAS __attribute__((address_space(3)))
#define GAS __attribute__((address_space(1)))
typedef unsigned short bf16;
typedef short bf16x8 __attribute__((ext_vector_type(8)));
typedef short s16x4 __attribute__((ext_vector_type(4)));
typedef float f32x4 __attribute__((ext_vector_type(4)));
typedef float f32x16 __attribute__((ext_vector_type(16)));
typedef unsigned u32x4 __attribute__((ext_vector_type(4)));
typedef unsigned u32x2 __attribute__((ext_vector_type(2)));
typedef GAS unsigned gu32;
#define RLX_AGENT __ATOMIC_RELAXED, __HIP_MEMORY_SCOPE_AGENT
using pg8::cvt_pk_bf16; using pg8::pack8; using pg8::unpack8; using pg8::bf2f; using pg8::sigmoidf_; using pg8::siluf_;
using pg8::O_Y; using pg8::O_RETP; using pg8::O_RETS; using pg8::O_KVP; using pg8::O_KVS; using pg8::O_WINP; using pg8::O_WINS; using pg8::O_SREP; using pg8::O_SIMP; using pg8::O_SRES; using pg8::O_SIMS; using pg8::O_END;

constexpr int TP = 16384, TS = 1024, TT = 17408;
__device__ __forceinline__ void sincos_d(double x, float& s, float& c) {
    const double TWO_PI = 6.283185307179586476925, PI = 3.14159265358979323846;
    double r = x - rint(x / TWO_PI) * TWO_PI; double sg = 1.0;
    if (r > 0.5 * PI) { r = PI - r; sg = -1.0; } else if (r < -0.5 * PI) { r = -PI - r; sg = -1.0; }
    const double r2 = r * r;
    const double sp = r * (1.0 + r2 * (-1.0 / 6 + r2 * (1.0 / 120 + r2 * (-1.0 / 5040 + r2 * (1.0 / 362880 + r2 * (-1.0 / 39916800 + r2 * (1.0 / 6227020800.0)))))));
    const double cp = 1.0 + r2 * (-0.5 + r2 * (1.0 / 24 + r2 * (-1.0 / 720 + r2 * (1.0 / 40320 + r2 * (-1.0 / 3628800 + r2 * (1.0 / 479001600.0 + r2 * (-1.0 / 87178291200.0)))))));
    s = (float)sp; c = (float)(sg * cp);
}

namespace at {
typedef LAS const char* lcp;
typedef short v4i16_t __attribute__((ext_vector_type(4)));
__device__ __forceinline__ int crow(int r, int hi) { return (r & 3) + 8 * (r >> 2) + 4 * hi; }
__device__ __forceinline__ f32x16 mfma32(bf16x8 a, bf16x8 b, f32x16 c) { return __builtin_amdgcn_mfma_f32_32x32x16_bf16(a, b, c, 0, 0, 0); }
__device__ __forceinline__ s16x4 vtr(lcp p) { return __builtin_bit_cast(s16x4, __builtin_amdgcn_ds_read_tr16_b64_v4i16((LAS v4i16_t*)p)); }
__device__ __forceinline__ void qkt(f32x16& p0, f32x16& p1, lcp Kslot, const bf16x8* qr, int r32, int hi) {
    lcp kb = Kslot + hi * 1024 + r32 * 16;
    f32x16 z;
#pragma unroll
    for (int r = 0; r < 16; ++r) z[r] = 0.f;
    p0 = z; p1 = z;
#pragma unroll
    for (int d0 = 0; d0 < 4; ++d0) {
        const bf16x8 b0 = *(LAS const bf16x8*)(kb + d0 * 2048), b1 = *(LAS const bf16x8*)(kb + d0 * 2048 + 512);
        p0 = mfma32(b0, qr[d0], p0); p1 = mfma32(b1, qr[d0], p1); }
}
__device__ __forceinline__ int vlane_off(int lane) { const int hi = lane >> 5; return ((lane >> 4) & 1) * 32 + (lane & 3) * 8 + (4 * hi + ((lane & 15) >> 2)) * 64; }
__device__ __forceinline__ void pv(f32x16* o, lcp vp, const bf16x8* pa) {
#pragma unroll
    for (int d0 = 0; d0 < 2; ++d0)
#pragma unroll
        for (int ks = 0; ks < 4; ++ks) {
            const s16x4 lo = vtr(vp + d0 * 4096 + ks * 1024), hh = vtr(vp + d0 * 4096 + ks * 1024 + 512);
            const bf16x8 vf = {lo[0], lo[1], lo[2], lo[3], hh[0], hh[1], hh[2], hh[3]};
            o[d0] = mfma32(pa[ks], vf, o[d0]); }
}
__device__ __forceinline__ bf16x8 pk8(const f32x16& p, int b) { u32x4 w; w.x = cvt_pk_bf16(p[b], p[b + 1]); w.y = cvt_pk_bf16(p[b + 2], p[b + 3]); w.z = cvt_pk_bf16(p[b + 4], p[b + 5]); w.w = cvt_pk_bf16(p[b + 6], p[b + 7]); return __builtin_bit_cast(bf16x8, w); }
__device__ __forceinline__ void pack_p(bf16x8* pa, const f32x16& p0, const f32x16& p1) { pa[0] = pk8(p0, 0); pa[1] = pk8(p0, 8); pa[2] = pk8(p1, 0); pa[3] = pk8(p1, 8); }
__device__ __forceinline__ float rowmax32(const f32x16& p0, const f32x16& p1) {
    float m = fmaxf(p0[0], p1[0]);
#pragma unroll
    for (int r = 1; r < 16; ++r) m = fmaxf(m, fmaxf(p0[r], p1[r]));
    return fmaxf(m, __shfl_xor(m, 32));
}
__device__ __forceinline__ void mask_tile(f32x16& p0, f32x16& p1, int lo_excl, int hi_incl, int hi) {
    const unsigned span = (unsigned)(hi_incl - lo_excl); const int base = 4 * hi - lo_excl - 1;
#pragma unroll
    for (int r = 0; r < 16; ++r) { const int cr = (r & 3) + 8 * (r >> 2);
        p0[r] = ((unsigned)(cr + base) < span) ? p0[r] : -INFINITY;
        p1[r] = ((unsigned)(cr + 32 + base) < span) ? p1[r] : -INFINITY; }
}
struct St { f32x16 o[2]; float m, l; };
__device__ __forceinline__ void st_init(St& s) {
#pragma unroll
    for (int r = 0; r < 16; ++r) { s.o[0][r] = 0.f; s.o[1][r] = 0.f; }
    s.m = -INFINITY; s.l = 0.f; }
__device__ __forceinline__ void st_update(St& st, f32x16& p0, f32x16& p1, lcp vp, LAS float* wsf, int r32, int hi) {
    const float rm = rowmax32(p0, p1);
    const float mn = fmaxf(st.m, rm);
    const float mu = (mn == -INFINITY) ? 0.f : mn;
    const float alpha = __builtin_amdgcn_exp2f(st.m - mu);
    float s = 0.f;
#pragma unroll
    for (int r = 0; r < 16; ++r) { p0[r] = __builtin_amdgcn_exp2f(p0[r] - mu); p1[r] = __builtin_amdgcn_exp2f(p1[r] - mu); s += p0[r] + p1[r]; }
    s += __shfl_xor(s, 32);
    st.l = st.l * alpha + s; st.m = mn;
    if (__builtin_amdgcn_ballot_w64(alpha != 1.f) != 0ull) {
        if (hi == 0) wsf[r32] = alpha;
#pragma unroll
        for (int r = 0; r < 16; ++r) { const float a = wsf[crow(r, hi)]; st.o[0][r] *= a; st.o[1][r] *= a; } }
    bf16x8 pa[4]; pack_p(pa, p0, p1);
    pv(st.o, vp, pa);
}
__device__ __forceinline__ void glds16(const void* gsrc, unsigned lds_dst) { unsigned keep;
    asm volatile("s_mov_b32 %0, m0\n\ts_mov_b32 m0, %2\n\ts_nop 0\n\tglobal_load_lds_dwordx4 %1, off\n\ts_mov_b32 m0, %0" : "=&s"(keep) : "v"(gsrc), "s"(lds_dst) : "memory"); }
#define AT_WAIT_BAR(N) asm volatile("s_waitcnt vmcnt(" #N ") lgkmcnt(0)\n\ts_barrier" ::: "memory")
__device__ __forceinline__ void acc_scaled(f32x16* fin, const f32x16* o, float w, LAS float* wsf, int r32, int hi) {
    if (hi == 0) wsf[r32] = w;
#pragma unroll
    for (int r = 0; r < 16; ++r) { const float a = wsf[crow(r, hi)]; fin[0][r] += a * o[0][r]; fin[1][r] += a * o[1][r]; }
}
__device__ __forceinline__ void acc_stage(LAS float* stg, const f32x16* o, float w, LAS float* wsf, int r32, int hi, bool first) {
    if (hi == 0) wsf[r32] = w;
#pragma unroll
    for (int r = 0; r < 16; ++r) { const int orow = crow(r, hi); const float a = wsf[orow];
        const float v0 = a * o[0][r], v1 = a * o[1][r];
        if (first) { stg[orow * 64 + r32] = v0; stg[orow * 64 + 32 + r32] = v1; } else { stg[orow * 64 + r32] += v0; stg[orow * 64 + 32 + r32] += v1; } }
}
__device__ __forceinline__ u32x4 ldk_reg(const bf16* src, int pitch, int wid, int lane) { return *(const u32x4*)(src + (size_t)lane * pitch + wid * 8); }
__device__ __forceinline__ u32x4 ldv_reg(const bf16* src, int pitch, int wid, int lane) { return *(const u32x4*)(src + (size_t)(16 * (wid & 3) + (lane >> 2)) * pitch + (wid >> 2) * 32 + (lane & 3) * 8); }
__device__ __forceinline__ void st_slot(LAS char* slot, u32x4 v, int wid, int lane) { *(LAS u32x4*)(slot + wid * 1024 + lane * 16) = v; }
__device__ __forceinline__ void wave_tile_f32(const float* ksrc, const float* vsrc, size_t rs, LAS char* kslot, LAS char* vslot, int lane) {
    const int q = lane & 15, rr = lane >> 4;
#pragma unroll 1
    for (int i0 = 0; i0 < 16; i0 += 4) {
        f32x4 kv[4], vv[4];
#pragma unroll
        for (int i = 0; i < 4; ++i) { const size_t ro = (size_t)(4 * (i0 + i) + rr) * rs + 4 * q; kv[i] = __builtin_nontemporal_load((const f32x4*)(ksrc + ro)); vv[i] = __builtin_nontemporal_load((const f32x4*)(vsrc + ro)); }
#pragma unroll
        for (int i = 0; i < 4; ++i) { const int row = 4 * (i0 + i) + rr;
            u32x2 a, b; a.x = cvt_pk_bf16(kv[i][0], kv[i][1]); a.y = cvt_pk_bf16(kv[i][2], kv[i][3]); b.x = cvt_pk_bf16(vv[i][0], vv[i][1]); b.y = cvt_pk_bf16(vv[i][2], vv[i][3]);
            *(LAS u32x2*)(kslot + (q >> 1) * 1024 + row * 16 + (q & 1) * 8) = a;
            *(LAS u32x2*)(vslot + (q >> 3) * 4096 + row * 64 + (q & 7) * 8) = b; }
    }
}
__device__ __forceinline__ void wave_tile_new8(const bf16* ksrc, const bf16* vsrc, LAS char* kslot, LAS char* vslot, int lane) {
#pragma unroll
    for (int i = 0; i < 8; ++i) { const int pid = lane + 64 * i, row = pid >> 3, ch = pid & 7;
        u32x4 k = {0u, 0u, 0u, 0u}, v = {0u, 0u, 0u, 0u};
        if (row < 8) { k = *(const u32x4*)(ksrc + row * 64 + ch * 8); v = *(const u32x4*)(vsrc + row * 64 + ch * 8); }
        *(LAS u32x4*)(kslot + ch * 1024 + row * 16) = k;
        *(LAS u32x4*)(vslot + (ch >> 2) * 4096 + row * 64 + (ch & 3) * 16) = v; }
}
}
constexpr int NWAVES = 8;
constexpr int LDS_BYTES = 163840;
constexpr int MISC_OFF = LDS_BYTES - 512;
constexpr size_t MiB = 1u << 20;
constexpr size_t WS_CTL = 0, CTL_ZERO_BYTES = 1 * MiB;
constexpr size_t WS_W0T = 1 * MiB, WS_WO0T = 9 * MiB, WS_W1T = 11 * MiB, WS_WGT = 15 * MiB, WS_WO1T = 19 * MiB;
constexpr size_t WS_WCT = 21 * MiB, WS_CCONST = 21 * MiB + 768 * 1024, WS_ROPEC = 22 * MiB, WS_ROPES = 22 * MiB + 512 * 1024;
constexpr size_t WS_MT = 24 * MiB, WS_BST = 32 * MiB, WS_CXT = 36 * MiB, WS_L16 = 40 * MiB, WS_L8I = 40 * MiB + 256 * 1024;
constexpr size_t WS_H0 = 48 * MiB, WS_QA = 84 * MiB, WS_KA = 94 * MiB, WS_VA = 104 * MiB, WS_ZA = 122 * MiB, WS_QN = 140 * MiB, WS_ZB = 158 * MiB, WS_GATES = 176 * MiB;
constexpr size_t WS_KXP = 180 * MiB, WS_KXS = 206 * MiB, WS_CKP = 208 * MiB, WS_CKS = 209 * MiB, WS_RETA = 218 * MiB, WS_MIX = 236 * MiB, WS_Y0B = 272 * MiB;
constexpr size_t WS_U = 308 * MiB, WS_Z1 = 344 * MiB, WS_YG = 380 * MiB, WS_V1 = 416 * MiB, WS_END = 452 * MiB;
constexpr int CW_TMO = 0, CW_WQ = 64  , CW_BAR = 4096, CW_SS = 16384  ;
static_assert((CW_SS + TT) * 4 <= (int)CTL_ZERO_BYTES, "ctl");

struct Frame {
    LAS unsigned char* lds; volatile LAS unsigned* MISC; gu32* ctl;
    int tid, lane, wave, G;
    const float* in[29]; const int* ptab; float* out; unsigned char* ws;
};
#define WSP(T, off) ((T*)(F.ws + (off)))
#define UNIT_IDS() int tid = F.tid; asm volatile("" : "+v"(tid)); const int lane = tid & 63; const int wid = __builtin_amdgcn_readfirstlane(tid >> 6); (void)lane; (void)wid

__device__ __forceinline__ float wave_sum(float v) {
#pragma unroll
    for (int o = 1; o < 64; o <<= 1) v += __shfl_xor(v, o);
    return v;
}
__device__ __forceinline__ int wq_next(Frame& F, int q) {
    __syncthreads();
    if (F.tid == 0) F.MISC[16] = __hip_atomic_fetch_add(F.ctl + CW_WQ + 64 * q, 1u, RLX_AGENT);
    __syncthreads();
    return (int)F.MISC[16];
}

__device__ __forceinline__ void nsa_imp(const f32x16& a0, const f32x16& a1, const f32x16& b0, const f32x16& b1, LAS float* imp, int lane) {
    const int r32 = lane & 31, hi = lane >> 5;
    float eprev = 0.f;
#pragma unroll
    for (int i = 0; i < 16; ++i) {
        const f32x16& X = (i < 4) ? a0 : (i < 8) ? a1 : (i < 12) ? b0 : b1; const int q4 = i & 3;
        const float G = (X[4 * q4] + X[4 * q4 + 1]) + (X[4 * q4 + 2] + X[4 * q4 + 3]), E = X[4 * q4 + 3];
        const float eo = __shfl_xor(E, 32);
        float v = G + (hi ? eo : eprev); eprev = eo;
        v += __shfl_xor(v, 1); v += __shfl_xor(v, 2);
        if ((r32 & 3) == 0) imp[(r32 >> 2) * 33 + 2 * i + hi] = v; }
}
__device__ __forceinline__ unsigned nsa_rank(LAS float* imp, int cur, bool samp, int lane) {
    const int r32 = lane & 31;
    const int q = lane >> 3, j = lane & 7;
    float sc[4]; int rk[4];
#pragma unroll
    for (int k = 0; k < 4; ++k) { const int s = 4 * j + k; const bool valid = s <= cur, forced = (s == 0) || (s == cur) || (s == cur - 1);
        sc[k] = valid ? (forced ? 1e4f : imp[q * 33 + s]) : -1e4f; rk[k] = (samp && !forced) ? 1 : 0; }
#pragma unroll 4
    for (int s2 = 0; s2 < 32; ++s2) {
        const bool valid = s2 <= cur, forced = (s2 == 0) || (s2 == cur) || (s2 == cur - 1);
        const float v2 = valid ? (forced ? 1e4f : imp[q * 33 + s2]) : -1e4f;
#pragma unroll
        for (int k = 0; k < 4; ++k) rk[k] += (v2 > sc[k] || (v2 == sc[k] && s2 < 4 * j + k)) ? 1 : 0; }
    unsigned mask = 0u;
#pragma unroll
    for (int k = 0; k < 4; ++k) if (4 * j + k <= cur && rk[k] < 8) mask |= 1u << (4 * j + k);
    mask |= __shfl_xor(mask, 1); mask |= __shfl_xor(mask, 2); mask |= __shfl_xor(mask, 4);
    return (unsigned)__shfl((int)mask, 8 * (r32 >> 2));
}

__device__ __forceinline__ void nsa_cmp(f32x16* oc, LAS float* imp, at::lcp k0, at::lcp k1, at::lcp v0, at::lcp v1, bool two, int nmax, const bf16x8* qr, int lane) {
    const int r32 = lane & 31, hi = lane >> 5;
    f32x16 a0, a1, b0, b1;
    at::qkt(a0, a1, k0, qr, r32, hi);
    if (two) at::qkt(b0, b1, k1, qr, r32, hi);
    at::mask_tile(a0, a1, -1, nmax < 0 ? -1 : (nmax > 63 ? 63 : nmax), hi);
    if (two) at::mask_tile(b0, b1, -1, nmax < 64 ? -1 : (nmax > 127 ? 63 : nmax - 64), hi);
    else {
#pragma unroll
        for (int r = 0; r < 16; ++r) { b0[r] = -INFINITY; b1[r] = -INFINITY; } }
    float rm = fmaxf(at::rowmax32(a0, a1), at::rowmax32(b0, b1));
    const float mu = (rm == -INFINITY) ? 0.f : rm;
    float s = 0.f;
#pragma unroll
    for (int r = 0; r < 16; ++r) { a0[r] = __builtin_amdgcn_exp2f(a0[r] - mu); a1[r] = __builtin_amdgcn_exp2f(a1[r] - mu); b0[r] = __builtin_amdgcn_exp2f(b0[r] - mu); b1[r] = __builtin_amdgcn_exp2f(b1[r] - mu);
        s += (a0[r] + a1[r]) + (b0[r] + b1[r]); }
    s += __shfl_xor(s, 32);
    const float inv = s > 0.f ? 1.f / s : 0.f;
#pragma unroll
    for (int r = 0; r < 16; ++r) { a0[r] *= inv; a1[r] *= inv; b0[r] *= inv; b1[r] *= inv; }
    nsa_imp(a0, a1, b0, b1, imp, lane);
    bf16x8 pa[4], pb[4]; at::pack_p(pa, a0, a1); at::pack_p(pb, b0, b1);
    asm volatile("" : "+v"(pa[0]), "+v"(pa[1]), "+v"(pa[2]), "+v"(pa[3]), "+v"(pb[0]), "+v"(pb[1]), "+v"(pb[2]), "+v"(pb[3]));
#pragma unroll
    for (int r = 0; r < 16; ++r) { oc[0][r] = 0.f; oc[1][r] = 0.f; }
    at::pv(oc, v0, pa);
    if (two) at::pv(oc, v1, pb);
}

__device__ __forceinline__ void nsa_prompt_unit(Frame& F, int b, int g, int c) {
    UNIT_IDS(); const int r32 = lane & 31, hi = lane >> 5;
    LAS char* L = (LAS char*)F.lds;
    LAS char* KS0 = L; LAS char* KS1 = L + 16384; LAS char* VS0 = L + 8192; LAS char* VS1 = L + 24576;
    LAS float* stg = (LAS float*)(L + 81920 + 8192 * wid); LAS float* wsf = (LAS float*)(L + 147456 + 512 * wid); LAS float* imp = (LAS float*)(L + 151552 + 1152 * wid);
    const int voff = at::vlane_off(lane);
    const int ql = 8 * wid + (r32 >> 2), h = r32 & 3, tpos = 64 * c + ql, head = 4 * g + h;
    const size_t token = (size_t)b * 2048 + tpos;
    const bf16* QN = WSP(const bf16, WS_QN); const float* GT = WSP(const float, WS_GATES);
    bf16x8 qr[4];
#pragma unroll
    for (int d0 = 0; d0 < 4; ++d0) qr[d0] = *(const bf16x8*)(QN + token * 512 + head * 64 + d0 * 16 + hi * 8);
    const float g0 = GT[token * 24 + head * 3 + 0], g1 = GT[token * 24 + head * 3 + 1], g2 = GT[token * 24 + head * 3 + 2];
    unsigned selm;
#ifndef X_NO_CMP
    {
        const bf16* CK = WSP(const bf16, WS_CKP) + ((size_t)(0 * 8 + b) * 2 + g) * 8192; const bf16* CV = WSP(const bf16, WS_CKP) + ((size_t)(1 * 8 + b) * 2 + g) * 8192;
        const bool two = c >= 16;
        at::st_slot(KS0, at::ldk_reg(CK, 64, wid, lane), wid, lane); at::st_slot(VS0, at::ldv_reg(CV, 64, wid, lane), wid, lane);
        if (two) { at::st_slot(KS1, at::ldk_reg(CK + 4096, 64, wid, lane), wid, lane); at::st_slot(VS1, at::ldv_reg(CV + 4096, 64, wid, lane), wid, lane); }
        __syncthreads();
        f32x16 oc[2];
        const int nmax = (tpos - 31) >> 4;
        nsa_cmp(oc, imp, KS0, KS1, VS0 + voff, VS1 + voff, two, nmax, qr, lane);
        selm = nsa_rank(imp, c, false, lane);
        at::acc_stage(stg, oc, g0, wsf, r32, hi, true);
        __syncthreads();
    }
#else
    selm = 0xffffffffu;
#endif
    __builtin_amdgcn_sched_barrier(0);
#ifndef X_NO_LOOP
    const unsigned lds0 = (unsigned)(size_t)L;
    const unsigned kdst = (unsigned)__builtin_amdgcn_readfirstlane((int)(lds0 + wid * 1024)), vdst = kdst + 8192;
    const int koff = lane * 64 + wid * 8, voffg = (16 * (wid & 3) + (lane >> 2)) * 64 + (wid >> 2) * 32 + (lane & 3) * 8;
    asm volatile("s_waitcnt vmcnt(0)" ::: "memory");
#pragma unroll 1
    for (int br = 0; br < 2; ++br) {
        const bf16* Kb = WSP(const bf16, WS_KXP) + ((size_t)((br ? 4 : 2) * 8 + b) * 2 + g) * 131072;
        const bf16* Vb = WSP(const bf16, WS_KXP) + ((size_t)((br ? 5 : 3) * 8 + b) * 2 + g) * 131072;
        const int t0 = br ? (c > 8 ? c - 8 : 0) : 0, nt = c - t0 + 1;
        at::St st; at::st_init(st);
#define NSA_DMA(j, slot) do { at::glds16(Kb + (size_t)(t0 + (j)) * 4096 + koff, kdst + (unsigned)(slot) * 16384u); at::glds16(Vb + (size_t)(t0 + (j)) * 4096 + voffg, vdst + (unsigned)(slot) * 16384u); } while (0)
        NSA_DMA(0, 0); if (nt > 1) NSA_DMA(1, 1); if (nt > 2) NSA_DMA(2, 2);
        int sl_cur = 0, sl_new = 3;
#pragma unroll 1
        for (int i = 0; i < nt; ++i) {
            const int t = t0 + i, ahead = nt - 1 - i;
            if (ahead >= 3) { NSA_DMA(i + 3, sl_new); sl_new = sl_new == 4 ? 0 : sl_new + 1; }
            if (ahead >= 3) AT_WAIT_BAR(6); else if (ahead == 2) AT_WAIT_BAR(4); else if (ahead == 1) AT_WAIT_BAR(2); else AT_WAIT_BAR(0);
            LAS char* Kc = L + sl_cur * 16384; LAS char* Vc = Kc + 8192; sl_cur = sl_cur == 4 ? 0 : sl_cur + 1;
            f32x16 p0, p1; at::qkt(p0, p1, Kc, qr, r32, hi);
            int lo_excl, hi_incl;
            if (br == 0) { lo_excl = -1; hi_incl = (t == c) ? ql : 63; if (!((selm >> t) & 1u)) hi_incl = -1; }
            else { lo_excl = (t == c - 8) ? ql : -1; hi_incl = (t == c) ? ql : 63; }
            at::mask_tile(p0, p1, lo_excl, hi_incl, hi);
            at::st_update(st, p0, p1, Vc + voff, wsf, r32, hi);
        }
#undef NSA_DMA
        at::acc_stage(stg, st.o, (br ? g2 : g1) / st.l, wsf, r32, hi, false);
        AT_WAIT_BAR(0);
    }
#endif
    __builtin_amdgcn_sched_barrier(0);
    const bf16* ZB = WSP(const bf16, WS_ZB); bf16* MIX = WSP(bf16, WS_MIX);
#pragma unroll
    for (int i = 0; i < 4; ++i) { const int row = i * 8 + (lane >> 3), ch = lane & 7;
        const size_t tok = (size_t)b * 2048 + 64 * c + 8 * wid + (row >> 2); const int hd = 4 * g + (row & 3);
        float z[8], v[8]; unpack8(*(const u32x4*)(ZB + tok * 512 + hd * 64 + ch * 8), z);
        const f32x4 x0 = *(LAS const f32x4*)(stg + row * 64 + ch * 8), x1 = *(LAS const f32x4*)(stg + row * 64 + ch * 8 + 4);
#pragma unroll
        for (int j = 0; j < 4; ++j) { v[j] = x0[j] * siluf_(z[j]); v[4 + j] = x1[j] * siluf_(z[4 + j]); }
        *(u32x4*)(MIX + tok * 1024 + 512 + hd * 64 + ch * 8) = pack8(v); }
}

__device__ __forceinline__ void nsa_sample_unit(Frame& F, int b, int g) {
    UNIT_IDS(); const int r32 = lane & 31, hi = lane >> 5;
    LAS char* L = (LAS char*)F.lds;
    LAS char* KP = L + 16384 * wid; LAS char* VP = KP + 8192;
    LAS float* wsf = (LAS float*)(L + 131072 + 512 * wid); LAS float* imp = (LAS float*)(L + 135168 + 1152 * wid);
    LAS float* MM = (LAS float*)(L + 144384); LAS float* LL = (LAS float*)(L + 146432); LAS float* OC = (LAS float*)(L + 148480); LAS float* GW = (LAS float*)(L + 156672);
    const int voff = at::vlane_off(lane);
    const int ql = r32 >> 2, h = r32 & 3, head = 4 * g + h;
    const size_t token = (size_t)TP + b * 8 + ql;
    const bf16* QN = WSP(const bf16, WS_QN); const float* GT = WSP(const float, WS_GATES);
    bf16x8 qr[4];
#pragma unroll
    for (int d0 = 0; d0 < 4; ++d0) qr[d0] = *(const bf16x8*)(QN + token * 512 + head * 64 + d0 * 16 + hi * 8);
    unsigned selm;
    {
        const bf16* CK = WSP(const bf16, WS_CKS) + ((size_t)(0 * 128 + b) * 2 + g) * 8192; const bf16* CV = WSP(const bf16, WS_CKS) + ((size_t)(1 * 128 + b) * 2 + g) * 8192;
        at::st_slot(L, at::ldk_reg(CK, 64, wid, lane), wid, lane); at::st_slot(L + 8192, at::ldv_reg(CV, 64, wid, lane), wid, lane);
        at::st_slot(L + 16384, at::ldk_reg(CK + 4096, 64, wid, lane), wid, lane); at::st_slot(L + 24576, at::ldv_reg(CV + 4096, 64, wid, lane), wid, lane);
        __syncthreads();
        f32x16 oc[2];
        nsa_cmp(oc, imp, L, L + 16384, L + 8192 + voff, L + 24576 + voff, true, 126, qr, lane);
        selm = nsa_rank(imp, 32, true, lane);
        if (wid == 0) {
#pragma unroll
            for (int r = 0; r < 16; ++r) { const int orow = at::crow(r, hi); OC[orow * 64 + r32] = oc[0][r]; OC[orow * 64 + 32 + r32] = oc[1][r]; }
            if (hi == 0) { GW[r32] = GT[token * 24 + head * 3 + 0]; GW[32 + r32] = GT[token * 24 + head * 3 + 1]; GW[64 + r32] = GT[token * 24 + head * 3 + 2]; } }
        __syncthreads();
    }
    unsigned un = selm;
#pragma unroll
    for (int o = 4; o < 32; o <<= 1) un |= __shfl_xor(un, o);
    un = (unsigned)__builtin_amdgcn_readfirstlane(un);
    at::St ss, sw; at::st_init(ss);
    const float* cache = F.in[2]; const float* cwin = F.in[3];
    const bf16* KXS = WSP(const bf16, WS_KXS);
    int idx = 0;
#pragma unroll 1
    for (int s = 0; s <= 32; ++s) {
        if (s < 32 && !((un >> s) & 1u)) continue;
        if (((idx++) & 7) != wid) continue;
        if (s < 32) { const int page = F.ptab[b * 16 + (s >> 1)];
            const float* base = cache + ((size_t)page * 128 + (s & 1) * 64) * 512 + g * 64;
            at::wave_tile_f32(base + 2 * 128, base + 3 * 128, 512, KP, VP, lane); }
        else at::wave_tile_new8(KXS + (size_t)2 * 131072 + (size_t)b * 1024 + g * 512, KXS + (size_t)3 * 131072 + (size_t)b * 1024 + g * 512, KP, VP, lane);
        f32x16 p0, p1; at::qkt(p0, p1, KP, qr, r32, hi);
        int hi_incl = s < 32 ? 63 : ql; if (s < 32 && !((selm >> s) & 1u)) hi_incl = -1;
        at::mask_tile(p0, p1, -1, hi_incl, hi);
        at::st_update(ss, p0, p1, VP + voff, wsf, r32, hi);
    }
    __builtin_amdgcn_sched_barrier(0);
    at::st_init(sw);
#pragma unroll 1
    for (int j = 0; j <= 8; ++j) {
        if (((idx++) & 7) != wid) continue;
        if (j < 8) { const float* base = cwin + ((size_t)b * 512 + 64 * j) * 256 + g * 64; at::wave_tile_f32(base, base + 128, 256, KP, VP, lane); }
        else at::wave_tile_new8(KXS + (size_t)4 * 131072 + (size_t)b * 1024 + g * 512, KXS + (size_t)5 * 131072 + (size_t)b * 1024 + g * 512, KP, VP, lane);
        f32x16 p0, p1; at::qkt(p0, p1, KP, qr, r32, hi);
        at::mask_tile(p0, p1, j == 0 ? ql : -1, j == 8 ? ql : 63, hi);
        at::st_update(sw, p0, p1, VP + voff, wsf, r32, hi);
    }
    if (hi == 0) { MM[(0 * 8 + wid) * 32 + r32] = ss.m; MM[(1 * 8 + wid) * 32 + r32] = sw.m; }
    __syncthreads();
    {
        float Ms = -INFINITY, Mw = -INFINITY;
#pragma unroll
        for (int w = 0; w < 8; ++w) { Ms = fmaxf(Ms, MM[(0 * 8 + w) * 32 + r32]); Mw = fmaxf(Mw, MM[(1 * 8 + w) * 32 + r32]); }
        const float fs = __builtin_amdgcn_exp2f(ss.m - Ms), fw = __builtin_amdgcn_exp2f(sw.m - Mw);
        if (hi == 0) { LL[(0 * 8 + wid) * 32 + r32] = ss.l * fs; LL[(1 * 8 + wid) * 32 + r32] = sw.l * fw; }
        LAS float* OPs = (LAS float*)(L + (0 * 8 + wid) * 8192); LAS float* OPw = (LAS float*)(L + (1 * 8 + wid) * 8192);
        if (hi == 0) wsf[r32] = fs;
#pragma unroll
        for (int r = 0; r < 16; ++r) { const int orow = at::crow(r, hi); const float a = wsf[orow]; OPs[orow * 64 + r32] = ss.o[0][r] * a; OPs[orow * 64 + 32 + r32] = ss.o[1][r] * a; }
        if (hi == 0) wsf[32 + r32] = fw;
#pragma unroll
        for (int r = 0; r < 16; ++r) { const int orow = at::crow(r, hi); const float a = wsf[32 + orow]; OPw[orow * 64 + r32] = sw.o[0][r] * a; OPw[orow * 64 + 32 + r32] = sw.o[1][r] * a; }
    }
    __syncthreads();
    {
        const int row = tid >> 4, dq = (tid & 15) * 4;
        f32x4 os = {0.f, 0.f, 0.f, 0.f}, ow = {0.f, 0.f, 0.f, 0.f}; float ls = 0.f, lw = 0.f;
#pragma unroll
        for (int w = 0; w < 8; ++w) { os = os + *(LAS const f32x4*)(L + (0 * 8 + w) * 8192 + (row * 64 + dq) * 4); ow = ow + *(LAS const f32x4*)(L + (1 * 8 + w) * 8192 + (row * 64 + dq) * 4);
            ls += LL[(0 * 8 + w) * 32 + row]; lw += LL[(1 * 8 + w) * 32 + row]; }
        const f32x4 oc = *(LAS const f32x4*)(OC + row * 64 + dq);
        const float w0 = GW[row], w1 = GW[32 + row] / ls, w2 = GW[64 + row] / lw;
        const size_t tok = (size_t)TP + b * 8 + (row >> 2); const int hd = 4 * g + (row & 3);
        const bf16* ZB = WSP(const bf16, WS_ZB); bf16* MIX = WSP(bf16, WS_MIX);
        const u32x2 zr = *(const u32x2*)(ZB + tok * 512 + hd * 64 + dq);
        const float z0 = __uint_as_float(zr.x << 16), z1 = __uint_as_float(zr.x & 0xffff0000u), z2 = __uint_as_float(zr.y << 16), z3 = __uint_as_float(zr.y & 0xffff0000u);
        const float v0 = (w0 * oc[0] + w1 * os[0] + w2 * ow[0]) * siluf_(z0), v1 = (w0 * oc[1] + w1 * os[1] + w2 * ow[1]) * siluf_(z1);
        const float v2 = (w0 * oc[2] + w1 * os[2] + w2 * ow[2]) * siluf_(z2), v3 = (w0 * oc[3] + w1 * os[3] + w2 * ow[3]) * siluf_(z3);
        u32x2 o; o.x = cvt_pk_bf16(v0, v1); o.y = cvt_pk_bf16(v2, v3);
        *(u32x2*)(MIX + tok * 1024 + 512 + hd * 64 + dq) = o;
    }
}
__device__ __forceinline__ float ret_log2g(int h) { return log2f(1.f - exp2f(-5.f - (float)h)); }
__device__ __forceinline__ void ret_r1_unit(Frame& F, int b, int h, int c) {
    UNIT_IDS();
    LAS float* Kd = (LAS float*)F.lds; LAS float* Vl = (LAS float*)(F.lds + 32768);
    const bf16* KA = WSP(const bf16, WS_KA); const bf16* VA = WSP(const bf16, WS_VA);
    const size_t tok0 = (size_t)b * 2048 + 128 * c; const float l2g = ret_log2g(h);
    for (int p = tid; p < 128 * 8; p += 512) { const int j = p >> 3, ch = p & 7; float v[8]; unpack8(*(const u32x4*)(KA + (tok0 + j) * 256 + h * 64 + ch * 8), v);
        const float dec = exp2f((float)(127 - j) * l2g);
        *(LAS f32x4*)(Kd + j * 64 + ch * 8) = (f32x4){v[0] * dec, v[1] * dec, v[2] * dec, v[3] * dec}; *(LAS f32x4*)(Kd + j * 64 + ch * 8 + 4) = (f32x4){v[4] * dec, v[5] * dec, v[6] * dec, v[7] * dec}; }
    for (int p = tid; p < 128 * 16; p += 512) { const int j = p >> 4, ch = p & 15; float v[8]; unpack8(*(const u32x4*)(VA + (tok0 + j) * 512 + h * 128 + ch * 8), v);
        *(LAS f32x4*)(Vl + j * 128 + ch * 8) = (f32x4){v[0], v[1], v[2], v[3]}; *(LAS f32x4*)(Vl + j * 128 + ch * 8 + 4) = (f32x4){v[4], v[5], v[6], v[7]}; }
    __syncthreads();
    const int dvq = tid & 31, dkg = tid >> 5;
    f32x4 acc[4];
#pragma unroll
    for (int i = 0; i < 4; ++i) acc[i] = (f32x4){0.f, 0.f, 0.f, 0.f};
#pragma unroll 4
    for (int j = 0; j < 128; ++j) { const f32x4 kk = *(LAS const f32x4*)(Kd + j * 64 + dkg * 4), vv = *(LAS const f32x4*)(Vl + j * 128 + dvq * 4);
#pragma unroll
        for (int i = 0; i < 4; ++i) acc[i] += kk[i] * vv; }
    float* A = WSP(float, WS_RETA) + ((size_t)(b * 4 + h) * 16 + c) * 8192;
#pragma unroll
    for (int i = 0; i < 4; ++i) *(f32x4*)(A + (dkg * 4 + i) * 128 + dvq * 4) = acc[i];
}
__device__ __forceinline__ void ret_r2_unit(Frame& F, int b, int h, int c) {
    UNIT_IDS(); const int r32 = lane & 31, hi = lane >> 5;
    LAS char* L = (LAS char*)F.lds;
    LAS float* stats = (LAS float*)(L + 65536);
    const bf16* QA = WSP(const bf16, WS_QA); const bf16* KA = WSP(const bf16, WS_KA); const bf16* VA = WSP(const bf16, WS_VA);
    const size_t tok0 = (size_t)b * 2048 + 128 * c; const float l2g = ret_log2g(h);
#pragma unroll
    for (int t = 0; t < 2; ++t) {
        at::st_slot(L + 8192 * t, *(const u32x4*)(KA + (tok0 + 64 * t + lane) * 256 + h * 64 + wid * 8), wid, lane);
#pragma unroll
        for (int i = 0; i < 2; ++i) { const int pid = tid + 512 * i, row = pid >> 4, q = pid & 15;
            *(LAS u32x4*)(L + 16384 + 16384 * t + (q >> 2) * 4096 + row * 64 + (q & 3) * 16) = *(const u32x4*)(VA + (tok0 + 64 * t + row) * 512 + h * 128 + q * 8); }
    }
    {
        const float* A = WSP(const float, WS_RETA) + (size_t)(b * 4 + h) * 16 * 8192; const float cd = exp2f(128.f * l2g);
        f32x4 s[4];
#pragma unroll
        for (int i = 0; i < 4; ++i) s[i] = (f32x4){0.f, 0.f, 0.f, 0.f};
#pragma unroll 1
        for (int cc0 = 0; cc0 < c; cc0 += 4) {
            f32x4 t[4][4]; float w[4];
#pragma unroll
            for (int j = 0; j < 4; ++j) { const int cc = cc0 + j < c ? cc0 + j : c - 1; w[j] = cc0 + j < c ? exp2f(128.f * l2g * (float)(c - 1 - cc)) : 0.f;
#pragma unroll
                for (int i = 0; i < 4; ++i) t[j][i] = *(const f32x4*)(A + (size_t)cc * 8192 + 4 * tid + 2048 * i); }
#pragma unroll
            for (int j = 0; j < 4; ++j)
#pragma unroll
                for (int i = 0; i < 4; ++i) s[i] += w[j] * t[j][i]; }
#pragma unroll
        for (int i = 0; i < 4; ++i) { const int e = 4 * tid + 2048 * i, dk = e >> 7, dv = e & 127;
            u32x2 w; w.x = cvt_pk_bf16(s[i][0], s[i][1]); w.y = cvt_pk_bf16(s[i][2], s[i][3]);
            *(LAS u32x2*)(L + 49152 + (dv >> 5) * 4096 + dk * 64 + (dv & 31) * 2) = w; }
        if (c == 15) {
#pragma unroll
            for (int i = 0; i < 4; ++i) { const f32x4 fin = s[i] * cd + *(const f32x4*)(A + (size_t)15 * 8192 + 4 * tid + 2048 * i);
                *(f32x4*)(F.out + O_RETP + (size_t)(b * 4 + h) * 8192 + 4 * tid + 2048 * i) = fin; } }
    }
    __syncthreads();
    const int wq = wid & 3, dvh = wid >> 2, i_row = 32 * wq + r32;
    const int voff = at::vlane_off(lane);
    f32x16 o[2];
#pragma unroll
    for (int r = 0; r < 16; ++r) { o[0][r] = 0.f; o[1][r] = 0.f; }
    const bf16* qrow = QA + (tok0 + i_row) * 256 + h * 64;
    {
        const float qd = exp2f((float)(i_row + 1) * l2g);
        bf16x8 pa[4];
#pragma unroll
        for (int ks = 0; ks < 4; ++ks) {
            const u32x2 lo2 = *(const u32x2*)(qrow + 16 * ks + 4 * hi), hi2 = *(const u32x2*)(qrow + 16 * ks + 8 + 4 * hi);
            u32x4 w; w.x = cvt_pk_bf16(__uint_as_float(lo2.x << 16) * qd, __uint_as_float(lo2.x & 0xffff0000u) * qd); w.y = cvt_pk_bf16(__uint_as_float(lo2.y << 16) * qd, __uint_as_float(lo2.y & 0xffff0000u) * qd);
            w.z = cvt_pk_bf16(__uint_as_float(hi2.x << 16) * qd, __uint_as_float(hi2.x & 0xffff0000u) * qd); w.w = cvt_pk_bf16(__uint_as_float(hi2.y << 16) * qd, __uint_as_float(hi2.y & 0xffff0000u) * qd);
            pa[ks] = __builtin_bit_cast(bf16x8, w); }
        at::pv(o, L + 49152 + dvh * 8192 + voff, pa);
    }
    bf16x8 qr[4];
#pragma unroll
    for (int d0 = 0; d0 < 4; ++d0) qr[d0] = *(const bf16x8*)(qrow + d0 * 16 + hi * 8);
#pragma unroll
    for (int t = 0; t < 2; ++t) {
        if (64 * t <= 32 * wq + 31) {
            f32x16 p0, p1; at::qkt(p0, p1, L + 8192 * t, qr, r32, hi);
#pragma unroll
            for (int r = 0; r < 16; ++r) { const int j0 = 64 * t + at::crow(r, hi), j1 = j0 + 32;
                p0[r] = (i_row >= j0) ? p0[r] * exp2f((float)(i_row - j0) * l2g) : 0.f;
                p1[r] = (i_row >= j1) ? p1[r] * exp2f((float)(i_row - j1) * l2g) : 0.f; }
            bf16x8 pa[4]; at::pack_p(pa, p0, p1);
            at::pv(o, L + 16384 + 16384 * t + dvh * 8192 + voff, pa);
        }
    }
    float sm[16], sq[16];
#pragma unroll
    for (int r = 0; r < 16; ++r) { sm[r] = o[0][r] + o[1][r]; sq[r] = o[0][r] * o[0][r] + o[1][r] * o[1][r]; }
#pragma unroll
    for (int r = 0; r < 16; ++r) {
#pragma unroll
        for (int off = 1; off < 32; off <<= 1) { sm[r] += __shfl_xor(sm[r], off); sq[r] += __shfl_xor(sq[r], off); }
        if (r32 == 0) { stats[(wid * 32 + at::crow(r, hi)) * 2] = sm[r]; stats[(wid * 32 + at::crow(r, hi)) * 2 + 1] = sq[r]; } }
    __syncthreads();
    const float* gn = F.in[11]; const bf16* ZA = WSP(const bf16, WS_ZA); bf16* MIX = WSP(bf16, WS_MIX);
    LAS float* stg = (LAS float*)(L + 73728 + 8192 * wid);
#pragma unroll
    for (int r = 0; r < 16; ++r) { const int row = at::crow(r, hi); const int pw = wid ^ 4;
        const float s1 = sm[r] + stats[(pw * 32 + row) * 2], s2 = sq[r] + stats[(pw * 32 + row) * 2 + 1];
        const float mu = s1 * (1.f / 128.f), var = s2 * (1.f / 128.f) - mu * mu, rstd = 1.f / sqrtf(var + 1e-6f);
        stg[row * 64 + r32] = (o[0][r] - mu) * rstd; stg[row * 64 + 32 + r32] = (o[1][r] - mu) * rstd; }
#pragma unroll
    for (int i = 0; i < 4; ++i) { const int row = i * 8 + (lane >> 3), ch = lane & 7; const size_t tok = tok0 + 32 * wq + row; const int cb = h * 128 + 64 * dvh + ch * 8;
        float z[8], v[8]; unpack8(*(const u32x4*)(ZA + tok * 512 + cb), z);
        const f32x4 x0 = *(LAS const f32x4*)(stg + row * 64 + ch * 8), x1 = *(LAS const f32x4*)(stg + row * 64 + ch * 8 + 4);
        const f32x4 g0 = *(const f32x4*)(gn + cb), g1 = *(const f32x4*)(gn + cb + 4);
#pragma unroll
        for (int j = 0; j < 4; ++j) { v[j] = x0[j] * g0[j] * siluf_(z[j]); v[4 + j] = x1[j] * g1[j] * siluf_(z[4 + j]); }
        *(u32x4*)(MIX + tok * 1024 + cb) = pack8(v); }
}
__device__ __forceinline__ void ret_sample_unit(Frame& F, int b, int h) {
    UNIT_IDS(); LAS char* L = (LAS char*)F.lds;
    LAS float* part = (LAS float*)L; LAS float* ql = (LAS float*)(L + 65536); LAS float* kl = (LAS float*)(L + 67584); LAS float* vl = (LAS float*)(L + 69632); LAS float* ol = (LAS float*)(L + 73728);
    const bf16* QA = WSP(const bf16, WS_QA); const bf16* KA = WSP(const bf16, WS_KA); const bf16* VA = WSP(const bf16, WS_VA);
    const size_t tok0 = (size_t)TP + b * 8; const float l2g = ret_log2g(h);
    { const int i = tid >> 6, d = tid & 63; ql[i * 64 + d] = bf2f(QA[(tok0 + i) * 256 + h * 64 + d]); kl[i * 64 + d] = bf2f(KA[(tok0 + i) * 256 + h * 64 + d]); }
    for (int p = tid; p < 8 * 128; p += 512) { const int i = p >> 7, d = p & 127; vl[p] = bf2f(VA[(tok0 + i) * 512 + h * 128 + d]); }
    __syncthreads();
    const int dvq = tid & 31, dkg = tid >> 5;
    const float* S0 = F.in[4] + (size_t)(b * 4 + h) * 8192; float* S1 = F.out + O_RETS + (size_t)(b * 4 + h) * 8192;
    f32x4 s[4];
#pragma unroll
    for (int i = 0; i < 4; ++i) s[i] = __builtin_nontemporal_load((const f32x4*)(S0 + (dkg * 4 + i) * 128 + dvq * 4));
#pragma unroll
    for (int t = 0; t < 8; ++t) { const float qd = exp2f((float)(t + 1) * l2g); f32x4 a = {0.f, 0.f, 0.f, 0.f};
#pragma unroll
        for (int i = 0; i < 4; ++i) a += (ql[t * 64 + dkg * 4 + i] * qd) * s[i];
        *(LAS f32x4*)(part + (dkg * 8 + t) * 128 + dvq * 4) = a; }
    const float cd = exp2f(8.f * l2g);
#pragma unroll
    for (int i = 0; i < 4; ++i) { f32x4 n = s[i] * cd;
#pragma unroll
        for (int j = 0; j < 8; ++j) n += (kl[j * 64 + dkg * 4 + i] * exp2f((float)(7 - j) * l2g)) * *(LAS const f32x4*)(vl + j * 128 + dvq * 4);
        *(f32x4*)(S1 + (dkg * 4 + i) * 128 + dvq * 4) = n; }
    __syncthreads();
    {
        const int t = wid;
        float o0 = 0.f, o1 = 0.f;
#pragma unroll
        for (int gq = 0; gq < 16; ++gq) { o0 += part[(gq * 8 + t) * 128 + lane]; o1 += part[(gq * 8 + t) * 128 + 64 + lane]; }
        for (int j = 0; j <= t; ++j) { float d = 0.f;
#pragma unroll 8
            for (int k = 0; k < 64; ++k) d += ql[t * 64 + k] * kl[j * 64 + k];
            d *= exp2f((float)(t - j) * l2g); o0 += d * vl[j * 128 + lane]; o1 += d * vl[j * 128 + 64 + lane]; }
        const float mu = wave_sum(o0 + o1) * (1.f / 128.f); const float var = wave_sum(o0 * o0 + o1 * o1) * (1.f / 128.f) - mu * mu, rstd = 1.f / sqrtf(var + 1e-6f);
        const float* gn = F.in[11]; const bf16* ZA = WSP(const bf16, WS_ZA); bf16* MIX = WSP(bf16, WS_MIX); const size_t tok = tok0 + t;
        const int c0 = h * 128 + lane, c1 = c0 + 64;
        const float y0 = (o0 - mu) * rstd * gn[c0] * siluf_(bf2f(ZA[tok * 512 + c0])), y1 = (o1 - mu) * rstd * gn[c1] * siluf_(bf2f(ZA[tok * 512 + c1]));
        MIX[tok * 1024 + c0] = (bf16)(cvt_pk_bf16(y0, 0.f) & 0xffffu); MIX[tok * 1024 + c1] = (bf16)(cvt_pk_bf16(y1, 0.f) & 0xffffu);
        (void)ol;
    }
}

__device__ __forceinline__ void cmp_unit(Frame& F, int b, int c, bool samp) {
    UNIT_IDS(); const int r32 = lane & 31, hi = lane >> 5;
    LAS char* L = (LAS char*)F.lds;
    const int g = wid >> 2, m = 32 * (wid & 3) + r32;
    const bf16* WCT = WSP(const bf16, WS_WCT) + (size_t)c * 131072;
    const float* srcf = nullptr; const bf16* srcb = nullptr;
    if (samp) { const int page = F.ptab[b * 16 + (m >> 3)]; srcf = F.in[2] + ((size_t)page * 128 + 16 * (m & 7)) * 512 + c * 128 + g * 64 + 8 * hi; }
    else srcb = WSP(const bf16, WS_KXP) + ((size_t)(c * 8 + b) * 2 + g) * 131072 + (size_t)(16 * m) * 64 + 8 * hi;
    f32x16 acc[4];
#pragma unroll
    for (int j = 0; j < 4; ++j)
#pragma unroll
        for (int r = 0; r < 16; ++r) acc[j][r] = 0.f;
#pragma unroll 1
    for (int kc = 0; kc < 2; ++kc) {
        __syncthreads();
#pragma unroll
        for (int i = 0; i < 16; ++i) { const int pid = tid + 512 * i, n = pid >> 6, q = pid & 63;
            *(LAS u32x4*)(L + n * 1040 + q * 16) = *(const u32x4*)(WCT + (size_t)n * 1024 + 512 * kc + q * 8); }
        __syncthreads();
#pragma unroll 4
        for (int ks = 0; ks < 32; ++ks) {
            const int kg = 512 * kc + 16 * ks, l = kg >> 6, d0 = kg & 63;
            bf16x8 a;
            if (samp) { const f32x4 x0 = __builtin_nontemporal_load((const f32x4*)(srcf + (size_t)l * 512 + d0)), x1 = __builtin_nontemporal_load((const f32x4*)(srcf + (size_t)l * 512 + d0 + 4));
                u32x4 w; w.x = cvt_pk_bf16(x0[0], x0[1]); w.y = cvt_pk_bf16(x0[2], x0[3]); w.z = cvt_pk_bf16(x1[0], x1[1]); w.w = cvt_pk_bf16(x1[2], x1[3]); a = __builtin_bit_cast(bf16x8, w); }
            else a = *(const bf16x8*)(srcb + l * 64 + d0);
#pragma unroll
            for (int j = 0; j < 4; ++j) { const bf16x8 bf = *(LAS const bf16x8*)(L + (32 * j + r32) * 1040 + (16 * ks + 8 * hi) * 2); acc[j] = at::mfma32(a, bf, acc[j]); }
        }
    }
    __syncthreads();
    LAS float* P1 = (LAS float*)L;
#pragma unroll
    for (int j = 2; j < 4; ++j)
#pragma unroll
        for (int r = 0; r < 16; ++r) { const int mm = 32 * (wid & 3) + at::crow(r, hi); P1[(g * 128 + mm) * 64 + 32 * (j - 2) + r32] = acc[j][r]; }
    __syncthreads();
    const float* cc = WSP(const float, WS_CCONST) + c * 64;
    bf16* dst = samp ? WSP(bf16, WS_CKS) + ((size_t)(c * 128 + b) * 2 + g) * 8192 : WSP(bf16, WS_CKP) + ((size_t)(c * 8 + b) * 2 + g) * 8192;
#pragma unroll
    for (int j = 0; j < 2; ++j)
#pragma unroll
        for (int r = 0; r < 16; ++r) { const int n = 32 * (wid & 3) + at::crow(r, hi), e = 32 * j + r32;
            const float v = n < 127 ? acc[j][r] + P1[(g * 128 + n + 1) * 64 + e] + cc[e] : 0.f;
            dst[n * 64 + e] = (bf16)(cvt_pk_bf16(v, 0.f) & 0xffffu); }
}
__device__ __forceinline__ f32x4 mfma16(bf16x8 a, bf16x8 b, f32x4 c) { return __builtin_amdgcn_mfma_f32_16x16x32_bf16(a, b, c, 0, 0, 0); }
__device__ __forceinline__ float gelu_tanh(float x) { const float u = 0.7978845608028654f * (x + 0.044715f * x * x * x); const float e = __expf(2.f * u); const float th = 1.f - 2.f / (e + 1.f); return 0.5f * x * (1.f + th); }
__device__ __forceinline__ void s5_unit(Frame& F, int g, int b, bool samp) {
    UNIT_IDS(); const int fr = lane & 15, fq = lane >> 4;
    LAS char* L = (LAS char*)F.lds; LAS char* UL = L; LAS char* LOC = L + 67584;
    const bf16* U = WSP(const bf16, WS_U) + (size_t)g * TT * 16;
    if (!samp) { const bf16* src = U + (size_t)b * 2048 * 16;
#pragma unroll
        for (int i = 0; i < 8; ++i) { const int pid = tid + 512 * i, m = pid >> 5, q = pid & 31; *(LAS u32x4*)(UL + m * 528 + q * 16) = *(const u32x4*)(src + (size_t)pid * 8); } }
    else { const bf16* src = U + (size_t)TP * 16;
#pragma unroll
        for (int i = 0; i < 8; ++i) { const int pid = tid + 512 * i, m = pid >> 5, q = pid & 31; u32x4 v = {0u, 0u, 0u, 0u}; if (q >= 16) v = *(const u32x4*)(src + (size_t)m * 128 + (q - 16) * 8); *(LAS u32x4*)(UL + m * 528 + q * 16) = v; } }
    __syncthreads();
    {
        const bf16* BST = WSP(const bf16, WS_BST) + (size_t)g * 128 * 256 + (size_t)(16 * wid + fr) * 256 + 8 * fq;
        bf16x8 bfr[8];
#pragma unroll
        for (int ks = 0; ks < 8; ++ks) bfr[ks] = *(const bf16x8*)(BST + 32 * ks);
#pragma unroll 2
        for (int mt = 0; mt < 8; ++mt) { f32x4 acc = {0.f, 0.f, 0.f, 0.f};
#pragma unroll
            for (int ks = 0; ks < 8; ++ks) { const bf16x8 a = *(LAS const bf16x8*)(UL + (16 * mt + fr) * 528 + (32 * ks + 8 * fq) * 2); acc = mfma16(a, bfr[ks], acc); }
#pragma unroll
            for (int r = 0; r < 4; ++r) *(LAS float*)(LOC + (16 * mt + 4 * fq + r) * 528 + (16 * wid + fr) * 4) = acc[r]; }
    }
    __syncthreads();
    if (!samp) {
        if (wid == 0) { const float ar = WSP(const float, WS_L16)[(g * 64 + lane) * 2], ai = WSP(const float, WS_L16)[(g * 64 + lane) * 2 + 1];
            float xr = 0.f, xi = 0.f;
            for (int m = 0; m < 128; ++m) { const float lr = *(LAS const float*)(LOC + m * 528 + lane * 4), li = *(LAS const float*)(LOC + m * 528 + 256 + lane * 4);
                __builtin_amdgcn_s_waitcnt(0xc07f);
                *(LAS bf16*)(LOC + m * 528 + lane * 2) = (bf16)(cvt_pk_bf16(xr, 0.f) & 0xffffu); *(LAS bf16*)(LOC + m * 528 + 128 + lane * 2) = (bf16)(cvt_pk_bf16(xi, 0.f) & 0xffffu);
                const float nr = ar * xr - ai * xi + lr, ni = ar * xi + ai * xr + li; xr = nr; xi = ni; }
            F.out[O_SREP + (size_t)(b * 64 + g) * 64 + lane] = xr; F.out[O_SIMP + (size_t)(b * 64 + g) * 64 + lane] = xi; }
    } else {
        const float ar = WSP(const float, WS_L16)[(g * 64 + lane) * 2], ai = WSP(const float, WS_L16)[(g * 64 + lane) * 2 + 1];
        const float br = WSP(const float, WS_L8I)[(g * 64 + lane) * 2], bi = WSP(const float, WS_L8I)[(g * 64 + lane) * 2 + 1];
        for (int m = wid; m < 128; m += 8) { const float lr = *(LAS const float*)(LOC + m * 528 + lane * 4), li = *(LAS const float*)(LOC + m * 528 + 256 + lane * 4);
            const float sr = F.in[5][(size_t)(m * 64 + g) * 64 + lane], si = F.in[6][(size_t)(m * 64 + g) * 64 + lane];
            const float xr = br * sr - bi * si, xi = br * si + bi * sr;
            __builtin_amdgcn_s_waitcnt(0xc07f);
            *(LAS bf16*)(LOC + m * 528 + lane * 2) = (bf16)(cvt_pk_bf16(xr, 0.f) & 0xffffu); *(LAS bf16*)(LOC + m * 528 + 128 + lane * 2) = (bf16)(cvt_pk_bf16(xi, 0.f) & 0xffffu);
            F.out[O_SRES + (size_t)(m * 64 + g) * 64 + lane] = ar * xr - ai * xi + lr; F.out[O_SIMS + (size_t)(m * 64 + g) * 64 + lane] = ar * xi + ai * xr + li; }
    }
    __syncthreads();
    if (!samp || wid >= 4) {
        const bf16* MT = WSP(const bf16, WS_MT) + (size_t)g * 256 * 256 + (size_t)(32 * wid + fr) * 256 + 8 * fq;
        const bf16* CXT = WSP(const bf16, WS_CXT) + (size_t)g * 256 * 128 + (size_t)(32 * wid + fr) * 128 + 8 * fq;
        bf16x8 bm[2][8], bc[2][4];
#pragma unroll
        for (int nt = 0; nt < 2; ++nt) {
#pragma unroll
            for (int ks = 0; ks < 8; ++ks) bm[nt][ks] = *(const bf16x8*)(MT + (size_t)nt * 16 * 256 + 32 * ks);
#pragma unroll
            for (int ks = 0; ks < 4; ++ks) bc[nt][ks] = *(const bf16x8*)(CXT + (size_t)nt * 16 * 128 + 32 * ks); }
        bf16* YG = WSP(bf16, WS_YG);
#pragma unroll 1
        for (int mt = 0; mt < 8; ++mt) { f32x4 acc[2] = {{0.f, 0.f, 0.f, 0.f}, {0.f, 0.f, 0.f, 0.f}};
#pragma unroll
            for (int ks = 0; ks < 8; ++ks) { const bf16x8 a = *(LAS const bf16x8*)(UL + (16 * mt + fr) * 528 + (32 * ks + 8 * fq) * 2); acc[0] = mfma16(a, bm[0][ks], acc[0]); acc[1] = mfma16(a, bm[1][ks], acc[1]); }
#pragma unroll
            for (int ks = 0; ks < 4; ++ks) { const bf16x8 a = *(LAS const bf16x8*)(LOC + (16 * mt + fr) * 528 + (32 * ks + 8 * fq) * 2); acc[0] = mfma16(a, bc[0][ks], acc[0]); acc[1] = mfma16(a, bc[1][ks], acc[1]); }
#pragma unroll
            for (int nt = 0; nt < 2; ++nt)
#pragma unroll
                for (int r = 0; r < 4; ++r) { const int m = 16 * mt + 4 * fq + r, t = 2 * wid + nt;
                    const size_t tok = samp ? (size_t)TP + 8 * m + (t - 8) : (size_t)b * 2048 + 16 * m + t;
                    YG[tok * 1024 + g * 16 + fr] = (bf16)(cvt_pk_bf16(gelu_tanh(acc[nt][r]), 0.f) & 0xffffu); }
        }
    }
}
__device__ __forceinline__ void s5_tables(Frame& F, int g) {
    const int tid = F.tid; LAS char* L = (LAS char*)F.lds;
    LAS float* POW = (LAS float*)L;
    LAS float* BB = (LAS float*)(L + 8704);
    LAS float* KT = (LAS float*)(L + 16896);
    LAS float* CC = (LAS float*)(L + 33280);
    const float* lre = F.in[18] + g * 64; const float* lim = F.in[19] + g * 64;
    const float dt = expf(F.in[25][g]);
    for (int p = tid; p < 64; p += 512) {
        const float lr = lre[p], li = lim[p];
        for (int tau = 0; tau <= 16; ++tau) { const float mg = expf((float)tau * lr * dt); float sn, cs; sincos_d((double)tau * (double)(li * dt), sn, cs); POW[(tau * 64 + p) * 2] = mg * cs; POW[(tau * 64 + p) * 2 + 1] = mg * sn; }
        { const float mg = expf(-8.f * lr * dt); float sn, cs; sincos_d(8.0 * (double)(li * dt), sn, cs); WSP(float, WS_L8I)[(g * 64 + p) * 2] = mg * cs; WSP(float, WS_L8I)[(g * 64 + p) * 2 + 1] = -mg * sn; }
    }
    __syncthreads();
    for (int e = tid; e < 1024; e += 512) { const int p = e >> 4, c = e & 15;
        const float lr = lre[p], li = lim[p], abr = POW[(64 + p) * 2], abi = POW[(64 + p) * 2 + 1], den = lr * lr + li * li, nr = abr - 1.f;
        const float fre = (nr * lr + abi * li) / den, fim = (abi * lr - nr * li) / den;
        const float br = F.in[20][(size_t)(g * 64 + p) * 16 + c], bi = F.in[21][(size_t)(g * 64 + p) * 16 + c];
        BB[e * 2] = fre * br - fim * bi; BB[e * 2 + 1] = fre * bi + fim * br;
        CC[(c * 64 + p) * 2] = F.in[22][(size_t)(g * 16 + c) * 64 + p]; CC[(c * 64 + p) * 2 + 1] = F.in[23][(size_t)(g * 16 + c) * 64 + p]; }
    if (tid < 64) { WSP(float, WS_L16)[(g * 64 + tid) * 2] = POW[(16 * 64 + tid) * 2]; WSP(float, WS_L16)[(g * 64 + tid) * 2 + 1] = POW[(16 * 64 + tid) * 2 + 1]; }
    __syncthreads();
    for (int e = tid; e < 4096; e += 512) { const int tau = e >> 8, c = (e >> 4) & 15, c2 = e & 15; float s = 0.f;
        for (int p = 0; p < 64; ++p) { const float cr = CC[(c * 64 + p) * 2], ci = CC[(c * 64 + p) * 2 + 1], pr = POW[(tau * 64 + p) * 2], pi = POW[(tau * 64 + p) * 2 + 1];
            const float wr = cr * pr - ci * pi, wi = cr * pi + ci * pr; s += wr * BB[(p * 16 + c2) * 2] - wi * BB[(p * 16 + c2) * 2 + 1]; }
        if (tau == 0 && c == c2) s += F.in[24][g * 16 + c];
        KT[e] = s; }
    __syncthreads();
    bf16* MT = WSP(bf16, WS_MT) + (size_t)g * 65536; bf16* BST = WSP(bf16, WS_BST) + (size_t)g * 32768; bf16* CXT = WSP(bf16, WS_CXT) + (size_t)g * 32768;
    for (int e = tid; e < 65536; e += 512) { const int n = e >> 8, k = e & 255, t = n >> 4, c = n & 15, s = k >> 4, c2 = k & 15;
        MT[e] = (bf16)(cvt_pk_bf16(t >= s ? KT[((t - s) * 16 + c) * 16 + c2] : 0.f, 0.f) & 0xffffu); }
    for (int e = tid; e < 32768; e += 512) { const int n = e >> 8, k = e & 255, p = n & 63, s = k >> 4, c2 = k & 15;
        const float pr = POW[((15 - s) * 64 + p) * 2], pi = POW[((15 - s) * 64 + p) * 2 + 1], br = BB[(p * 16 + c2) * 2], bi = BB[(p * 16 + c2) * 2 + 1];
        BST[e] = (bf16)(cvt_pk_bf16(n < 64 ? pr * br - pi * bi : pr * bi + pi * br, 0.f) & 0xffffu); }
    for (int e = tid; e < 32768; e += 512) { const int n = e >> 7, k = e & 127, t = n >> 4, c = n & 15, p = k & 63;
        const float cr = CC[(c * 64 + p) * 2], ci = CC[(c * 64 + p) * 2 + 1], pr = POW[((t + 1) * 64 + p) * 2], pi = POW[((t + 1) * 64 + p) * 2 + 1];
        CXT[e] = (bf16)(cvt_pk_bf16(k < 64 ? cr * pr - ci * pi : -(cr * pi + ci * pr), 0.f) & 0xffffu); }
    __syncthreads();
}
#define XB_TMO      128
#define XB_XCNT(j)  (256  + 64 * (j))
#define XB_XSUB(j)  (1280 + 64 * (j))
#define XB_XGEN(j)  (2304 + 64 * (j))
#define XB_TOP      3328
#define XB_TOPGEN   3392
#define XCD_BAR_WORDS 3456
#define XB_SPIN_CAP (1u << 18)
__device__ __forceinline__ unsigned xb_ld(unsigned* p)              { return __hip_atomic_load(p, __ATOMIC_RELAXED, __HIP_MEMORY_SCOPE_AGENT); }
__device__ __forceinline__ unsigned xb_add(unsigned* p, unsigned v) { return __hip_atomic_fetch_add(p, v, __ATOMIC_RELAXED, __HIP_MEMORY_SCOPE_AGENT); }
__device__ __forceinline__ unsigned xb_xcc_id() { return (unsigned)__builtin_amdgcn_s_getreg((3 << 11) | 20) & 0xFu; }
#define XB_SPIN(cond, bar) do { unsigned _sp = 0; while (cond) { __builtin_amdgcn_s_sleep(1); \
    if ((++_sp & 255u) == 0u) { if (xb_ld(&(bar)[XB_TMO])) break; if (_sp > XB_SPIN_CAP) { atomicAdd(&(bar)[XB_TMO], 1u); break; } } } } while (0)
struct XcdBarrier { unsigned* bar; unsigned x; volatile LAS unsigned* st; };
__device__ __forceinline__ XcdBarrier xcd_barrier_post(unsigned* bar, volatile LAS unsigned* st) {
    XcdBarrier b; b.bar = bar; b.x = xb_xcc_id(); b.st = st;
    if (threadIdx.x == 0) (void)xb_add(&bar[XB_XCNT(b.x)], 1u);
    return b;
}
__device__ __forceinline__ void xcd_barrier_complete(unsigned* bar, unsigned x, unsigned& nloc, unsigned& nx) {
    const unsigned G = gridDim.x * gridDim.y * gridDim.z;
    unsigned sum, cnt, mine, sp = 0u;
    for (;;) {
        sum = 0u; cnt = 0u; mine = 0u;
#pragma unroll
        for (unsigned j = 0; j < 16; ++j) { const unsigned c = xb_ld(&bar[XB_XCNT(j)]); sum += c; cnt += (c > 0u) ? 1u : 0u; mine = (j == x) ? c : mine; }
        if (sum == G) break;
        __builtin_amdgcn_s_sleep(1);
        if ((++sp & 255u) == 0u) { if (xb_ld(&bar[XB_TMO])) break; if (sp > XB_SPIN_CAP) { atomicAdd(&bar[XB_TMO], 1u); break; } }
    }
    nloc = mine > 0u ? mine : 1u; nx = cnt > 0u ? cnt : 1u;
}
__device__ __forceinline__ void xcd_barrier(const XcdBarrier& b) {
    asm volatile("s_waitcnt vmcnt(0)" ::: "memory");
    __syncthreads();
    if (threadIdx.x == 0) {
        unsigned* bar = b.bar;
        __builtin_amdgcn_s_waitcnt(0);
        unsigned nloc = b.st[0], nx = b.st[1];
        if (nloc == 0u) { xcd_barrier_complete(bar, b.x, nloc, nx); b.st[0] = nloc; b.st[1] = nx; }
        const unsigned old = xb_add(&bar[XB_XSUB(b.x)], 1u);
        const unsigned gen = old / nloc;
        if (old + 1u == (gen + 1u) * nloc) {
            __builtin_amdgcn_fence(__ATOMIC_RELEASE, "agent");
            asm volatile("s_waitcnt vmcnt(0)" ::: "memory");
            const unsigned og = xb_add(&bar[XB_TOP], 1u);
            const unsigned tg = og / nx;
            if (og + 1u == (tg + 1u) * nx) xb_add(&bar[XB_TOPGEN], 1u);
            else XB_SPIN(xb_ld(&bar[XB_TOPGEN]) == tg, bar);
            __builtin_amdgcn_fence(__ATOMIC_ACQUIRE, "agent");
            xb_add(&bar[XB_XGEN(b.x)], 1u);
            asm volatile("s_waitcnt vmcnt(0)" ::: "memory");
        } else {
            XB_SPIN(xb_ld(&bar[XB_XGEN(b.x)]) == gen, bar);
            __builtin_amdgcn_fence(__ATOMIC_ACQUIRE, "agent");
            asm volatile("s_waitcnt vmcnt(0)" ::: "memory");
        }
    }
    __syncthreads();
}

__device__ __forceinline__ int l0_src_col(int np) { const int pn = np >> 8, bj = (np >> 7) & 1, wc = (np >> 5) & 3, j = np & 31, rc = 256 * pn + 64 * wc + 32 * bj + j;
    return rc < 2816 ? rc : rc < 3328 ? rc + 24 : rc < 3352 ? rc - 3328 + 2816 : -1; }
__device__ __forceinline__ void p0_transpose_item(const float* W, const float* W2, int K, int N, bf16* WT, int nblk, int kind, const float* gain, LAS float* scr, int item, int lane) {
    const int kb = item / nblk, nb = item % nblk, k0 = 64 * kb, n0 = 32 * nb;
    const int np = n0 + (lane & 31); int sc = np; const float* Ws = W;
    if (kind == 1) sc = l0_src_col(np);
    else if (kind == 2) { const int pn = np >> 8, bj = (np >> 7) & 1, wc = (np >> 5) & 3, j = np & 31; sc = 128 * pn + 32 * wc + j; Ws = bj ? W2 : W; }
#pragma unroll 8
    for (int i = 0; i < 32; ++i) { const int kk = 2 * i + (lane >> 5); float v = 0.f; if (sc >= 0) { v = Ws[(size_t)(k0 + kk) * N + sc]; if (gain) v *= gain[k0 + kk]; } scr[kk * 33 + (lane & 31)] = v; }
    asm volatile("s_waitcnt lgkmcnt(0)" ::: "memory");
    const int c = lane & 7;
#pragma unroll
    for (int j = 0; j < 4; ++j) { const int n = (lane >> 3) + 8 * j; const LAS float* s = scr + (8 * c) * 33 + n;
        u32x4 o; o.x = cvt_pk_bf16(s[0 * 33], s[1 * 33]); o.y = cvt_pk_bf16(s[2 * 33], s[3 * 33]); o.z = cvt_pk_bf16(s[4 * 33], s[5 * 33]); o.w = cvt_pk_bf16(s[6 * 33], s[7 * 33]);
        *(u32x4*)(WT + (size_t)(n0 + n) * K + k0 + 8 * c) = o; }
    asm volatile("s_waitcnt lgkmcnt(0)" ::: "memory");
}
__device__ __forceinline__ void p0_prologue(Frame& F) {
    const int tid = F.tid, lane = F.lane;
    LAS float* scr = (LAS float*)(F.lds + F.wave * 16384);
    const int gw = (int)blockIdx.x * NWAVES + F.wave, NGW = F.G * NWAVES;
    constexpr int I0 = 16 * 112, IO0 = 16 * 32, I1 = 16 * 64, IG = 16 * 64, IO1 = 16 * 32;
    for (int it = gw; it < I0 + IO0 + I1 + IG + IO1; it += NGW) {
        int r = it;
        if (r < I0) { p0_transpose_item(F.in[9], nullptr, 1024, 3352, WSP(bf16, WS_W0T), 112, 1, F.in[8], scr, r, lane); continue; } r -= I0;
        if (r < IO0) { p0_transpose_item(F.in[10], nullptr, 1024, 1024, WSP(bf16, WS_WO0T), 32, 0, nullptr, scr, r, lane); continue; } r -= IO0;
        if (r < I1) { p0_transpose_item(F.in[17], nullptr, 1024, 2048, WSP(bf16, WS_W1T), 64, 0, F.in[16], scr, r, lane); continue; } r -= I1;
        if (r < IG) { p0_transpose_item(F.in[26], F.in[27], 1024, 1024, WSP(bf16, WS_WGT), 64, 2, nullptr, scr, r, lane); continue; } r -= IG;
        p0_transpose_item(F.in[28], nullptr, 1024, 1024, WSP(bf16, WS_WO1T), 32, 0, nullptr, scr, r, lane);
    }
    for (int m = gw; m < TT; m += NGW) {
        const float* xrow = m < TP ? F.in[0] + (size_t)m * 1024 : F.in[1] + (size_t)(m - TP) * 1024;
        const f32x4* xr = (const f32x4*)xrow + lane; f32x4 v[4]; float s = 0.f;
#pragma unroll
        for (int j = 0; j < 4; ++j) { v[j] = xr[64 * j]; s += (v[j].x * v[j].x + v[j].y * v[j].y) + (v[j].z * v[j].z + v[j].w * v[j].w); }
        const float rstd = 1.f / sqrtf(wave_sum(s) * (1.f / 1024.f) + 1e-6f);
        u32x2* o8 = (u32x2*)(WSP(bf16, WS_H0) + (size_t)m * 1024) + lane;
#pragma unroll
        for (int j = 0; j < 4; ++j) { u32x2 w; w.x = cvt_pk_bf16(v[j].x * rstd, v[j].y * rstd); w.y = cvt_pk_bf16(v[j].z * rstd, v[j].w * rstd); o8[64 * j] = w; }
    }
    const int gt = (int)blockIdx.x * 512 + tid, NGT = F.G * 512;
    for (int e = gt; e < 2056 * 32; e += NGT) { const int pos = e >> 5, i = e & 31; const float inv = (float)exp(-(double)i * (9.210340371976184 / 32.0)); const float ang = (float)pos * inv; float s, c; sincos_d((double)ang, s, c);
        WSP(float, WS_ROPEC)[e] = c; WSP(float, WS_ROPES)[e] = s; }
    for (int e = gt; e < 2 * 128 * 1024; e += NGT) { const int c = e >> 17, n = (e >> 10) & 127, k = e & 1023, r = n >> 6, ee = n & 63, l = k >> 6, d = k & 63;
        WSP(bf16, WS_WCT)[e] = (bf16)(cvt_pk_bf16(F.in[15][(((size_t)c * 32 + 16 * r + l) * 64 + d) * 64 + ee], 0.f) & 0xffffu); }
    for (int o = gw; o < 128; o += NGW) { const int c = o >> 6, e = o & 63; float s = 0.f;
        for (int k = lane; k < 2048; k += 64) s += F.in[14][(size_t)c * 2048 + k] * F.in[15][((size_t)c * 2048 + k) * 64 + e];
        s = wave_sum(s); if (lane == 0) WSP(float, WS_CCONST)[o] = s; }
}

__device__ __forceinline__ void wincopy_item(Frame& F, int bb) {
    const f32x4* src = (const f32x4*)F.in[3] + (size_t)bb * 512 * 64 + 8 * 64; f32x4* dst = (f32x4*)(F.out + O_WINS) + (size_t)bb * 512 * 64;
    for (int e = F.tid; e < 504 * 64; e += 512 * 4) {
        f32x4 v[4];
#pragma unroll
        for (int j = 0; j < 4; ++j) if (e + 512 * j < 504 * 64) v[j] = __builtin_nontemporal_load(src + e + 512 * j);
#pragma unroll
        for (int j = 0; j < 4; ++j) if (e + 512 * j < 504 * 64) __builtin_nontemporal_store(v[j], dst + e + 512 * j); }
}
constexpr int N_PHASES = 9;
#ifndef MK_N_LAUNCHES
#define MK_N_LAUNCHES 9
#endif
struct Args { const void* in[29]; float* out; unsigned char* ws; int ph_lo, ph_hi; };
__global__ void __launch_bounds__(NWAVES * 64, 2) mega_fwd(Args args) {
    extern __shared__ __attribute__((aligned(16))) unsigned char lds[];
    Frame F;
    F.lds = (LAS unsigned char*)lds; F.MISC = (volatile LAS unsigned*)(F.lds + MISC_OFF);
    F.tid = threadIdx.x; F.lane = F.tid & 63; F.wave = __builtin_amdgcn_readfirstlane(F.tid >> 6); F.G = gridDim.x;
#pragma unroll
    for (int i = 0; i < 29; ++i) F.in[i] = (const float*)args.in[i];
    F.ptab = (const int*)args.in[7]; F.out = args.out; F.ws = args.ws; F.ctl = (gu32*)(args.ws + WS_CTL);
    for (int u = F.tid; u < 128; u += NWAVES * 64) F.MISC[u] = 0u;
    __syncthreads();
    XcdBarrier bar; bar.bar = (unsigned*)(F.ctl + CW_BAR); bar.x = 0; bar.st = nullptr;
    if (MK_N_LAUNCHES == 1) bar = xcd_barrier_post((unsigned*)(F.ctl + CW_BAR), F.MISC + 8);
    const int lo = args.ph_lo, hi = args.ph_hi;
#ifdef ONLY_PHASE
#define IN(k) ((k) == ONLY_PHASE && lo <= (k) && (k) < hi)
#else
#define IN(k) (lo <= (k) && (k) < hi)
#endif
#ifdef EXTRA_BAR
#define SEAM(k) do { if (IN(k) && IN((k) + 1)) { xcd_barrier(bar); xcd_barrier(bar); } } while (0)
#else
#define SEAM(k) do { if (IN(k) && IN((k) + 1)) xcd_barrier(bar); } while (0)
#endif
    LAS unsigned char* ring = F.lds;

    if (IN(0)) { p0_prologue(F);
#if defined(DUP_PHASE) && DUP_PHASE == 0
        __syncthreads(); p0_prologue(F);
#endif
    }
    SEAM(0);
    if (IN(1)) {
        pg8::Gemm g{WSP(const pg8::bf16_t, WS_H0), WSP(const pg8::bf16_t, WS_W0T), TT, 3584, 1024}; pg8::StaticOrder S; S.init(TT, 3584, F.G, (int)blockIdx.x);
        pg8::EpiL0 E{WSP(bf16, WS_QA), WSP(bf16, WS_KA), WSP(bf16, WS_VA), WSP(bf16, WS_ZA), WSP(bf16, WS_QN), WSP(bf16, WS_ZB), WSP(bf16, WS_KXP), WSP(bf16, WS_KXS), WSP(float, WS_GATES), F.out,
                     WSP(const float, WS_ROPEC), WSP(const float, WS_ROPES), F.in[12], F.in[13]};
        pg8::gemm_phase<pg8::EpiL0, pg8::StaticOrder, true, true>(ring, g, S, E);
#if defined(DUP_PHASE) && DUP_PHASE == 1
        __syncthreads(); pg8::gemm_phase<pg8::EpiL0, pg8::StaticOrder, true, true>(ring, g, S, E);
#endif
    }
    SEAM(1);
    if (IN(2)) {
#if defined(DUP_PHASE) && DUP_PHASE == 2
        for (int rep = 0; rep < 2; ++rep)
        for (;;) { const int it = wq_next(F, rep ? 4 : 0); if (it >= 256 + 16 + 512 + 512 + 64 + 128) break;
#else
        for (;;) { const int it = wq_next(F, 0); if (it >= 256 + 16 + 512 + 512 + 64 + 128) break;
#endif
            if (it < 256) cmp_unit(F, it >> 1, it & 1, true);
            else if (it < 272) cmp_unit(F, (it - 256) >> 1, (it - 256) & 1, false);
            else if (it < 784) { const int u = it - 272; ret_r1_unit(F, u >> 6, (u >> 4) & 3, u & 15); }
            else if (it < 1296) { const int u = it - 784; ret_sample_unit(F, u >> 2, u & 3); }
            else if (it < 1360) s5_tables(F, it - 1296);
            else wincopy_item(F, it - 1360); }
    }
    SEAM(2);
    if (IN(3)) {
#if defined(DUP_PHASE) && DUP_PHASE == 3
        for (int rep = 0; rep < 2; ++rep)
        for (;;) { const int it = wq_next(F, rep ? 5 : 1); if (it >= 256 + 256 + 256 + 512) break;
#else
        for (;;) { const int it = wq_next(F, 1); if (it >= 256 + 256 + 256 + 512) break;
#endif
#if defined(DUP_PHASE) && DUP_PHASE == 3 && defined(DUP3_KIND)
            const int kmask = rep ? DUP3_KIND : 7;
#else
            const int kmask = 7;
#endif
            if (it < 256 || (it >= 512 && it < 768)) { const int u = it < 256 ? it : it - 256; const int c = 31 - (u >> 4), bg = u & 15;
                if (kmask & 1) nsa_prompt_unit(F, bg >> 1, bg & 1, c); }
            else if (it < 512) { const int u = it - 256;
                if (kmask & 2) nsa_sample_unit(F, u >> 1, u & 1); }
            else { const int u = it - 768;
                if (kmask & 4) ret_r2_unit(F, u >> 6, (u >> 4) & 3, u & 15); } }
    }
    SEAM(3);
    if (IN(4)) {
        pg8::Gemm g{WSP(const pg8::bf16_t, WS_MIX), WSP(const pg8::bf16_t, WS_WO0T), TT, 1024, 1024}; pg8::StaticOrder S; S.init(TT, 1024, F.G, (int)blockIdx.x);
        pg8::EpiOut0 E{F.in[0], F.in[1], F.out + O_Y, WSP(bf16, WS_Y0B), (float*)(F.ctl + CW_SS)};
        pg8::gemm_phase<pg8::EpiOut0, pg8::StaticOrder, true, true>(ring, g, S, E);
    }
    SEAM(4);
    if (IN(5)) {
        pg8::Gemm g{WSP(const pg8::bf16_t, WS_Y0B), WSP(const pg8::bf16_t, WS_W1T), TT, 2048, 1024}; pg8::StaticOrder S; S.init(TT, 2048, F.G, (int)blockIdx.x);
        pg8::EpiL1 E{(const float*)(F.ctl + CW_SS), WSP(bf16, WS_U), WSP(bf16, WS_Z1)};
        pg8::gemm_phase<pg8::EpiL1, pg8::StaticOrder, true, true>(ring, g, S, E);
#if defined(DUP_PHASE) && DUP_PHASE == 5
        __syncthreads(); pg8::gemm_phase<pg8::EpiL1, pg8::StaticOrder, true, true>(ring, g, S, E);
#endif
    }
    SEAM(5);
    if (IN(6)) {
#if defined(DUP_PHASE) && DUP_PHASE == 6
        for (int rep = 0; rep < 2; ++rep)
        for (;;) { const int it = wq_next(F, rep ? 6 : 2); if (it >= 576) break;
#else
        for (;;) { const int it = wq_next(F, 2); if (it >= 576) break;
#endif
            if (it < 512) s5_unit(F, it & 63, it >> 6, false); else s5_unit(F, it - 512, 0, true); }
    }
    SEAM(6);
    if (IN(7)) {
        pg8::Gemm g{WSP(const pg8::bf16_t, WS_YG), WSP(const pg8::bf16_t, WS_WGT), TT, 2048, 1024}; pg8::StaticOrder S; S.init(TT, 2048, F.G, (int)blockIdx.x);
        pg8::EpiGLU E{WSP(const bf16, WS_Z1), WSP(bf16, WS_V1)};
        pg8::gemm_phase<pg8::EpiGLU, pg8::StaticOrder, true, true>(ring, g, S, E);
#if defined(DUP_PHASE) && DUP_PHASE == 7
        __syncthreads(); pg8::gemm_phase<pg8::EpiGLU, pg8::StaticOrder, true, true>(ring, g, S, E);
#endif
    }
    SEAM(7);
    if (IN(8)) {
        pg8::Gemm g{WSP(const pg8::bf16_t, WS_V1), WSP(const pg8::bf16_t, WS_WO1T), TT, 1024, 1024}; pg8::StaticOrder S; S.init(TT, 1024, F.G, (int)blockIdx.x);
        pg8::EpiFinal E{F.out + O_Y};
        pg8::gemm_phase<pg8::EpiFinal, pg8::StaticOrder, true, true>(ring, g, S, E);
    }
#undef IN
#undef SEAM
}

extern "C" void kernel_launch(void* const* d_in, const int* in_sizes, int n_in, void* d_out, int out_size, void* d_ws, size_t ws_size, hipStream_t stream) {
    static int grid = 0;
    if (grid == 0) {
        if (n_in != 29 || out_size != (int)O_END || ws_size < WS_END) { fprintf(stderr, "kernel_launch: unexpected shapes (n_in %d, out %d, ws %zu); nothing launched\n", n_in, out_size, ws_size); grid = -1; return; }
        int dev = 0, cus = 0, per_cu = 0;
        if (hipGetDevice(&dev) != hipSuccess || hipDeviceGetAttribute(&cus, hipDeviceAttributeMultiprocessorCount, dev) != hipSuccess) { grid = -1; return; }
        if (hipFuncSetAttribute((const void*)mega_fwd, hipFuncAttributeMaxDynamicSharedMemorySize, LDS_BYTES) != hipSuccess) { fprintf(stderr, "kernel_launch: hipFuncSetAttribute failed\n"); grid = -1; return; }
        if (hipOccupancyMaxActiveBlocksPerMultiprocessor(&per_cu, (const void*)mega_fwd, NWAVES * 64, LDS_BYTES) != hipSuccess || per_cu < 1) { fprintf(stderr, "kernel_launch: occupancy query says %d\n", per_cu); per_cu = 1; }
        (void)hipGetLastError();
        grid = cus;
    }
    if (grid < 0) return;
    (void)hipMemsetAsync((char*)d_ws + WS_CTL, 0, CTL_ZERO_BYTES, stream);
    Args a{};
    for (int i = 0; i < 29; ++i) a.in[i] = d_in[i];
    a.out = (float*)d_out; a.ws = (unsigned char*)d_ws;
    if (MK_N_LAUNCHES == 1) {
        a.ph_lo = 0; a.ph_hi = N_PHASES;
        void* kargs[] = {&a};
        hipError_t e = hipLaunchCooperativeKernel((const void*)mega_fwd, dim3(grid), dim3(NWAVES * 64), kargs, LDS_BYTES, stream);
        if (e != hipSuccess) fprintf(stderr, "kernel_launch: cooperative launch failed: %s (grid %d)\n", hipGetErrorString(e), grid);
    } else {
        for (int p = 0; p < N_PHASES; ++p) { a.ph_lo = p; a.ph_hi = p + 1; hipLaunchKernelGGL(mega_fwd, dim3(grid), dim3(NWAVES * 64), LDS_BYTES, stream, a); }
    }
}
```
